# Optimizing an MI355X kernel written in HIP

```python
import jax, jax.numpy as jnp
from jax import lax
import numpy as np

D_MODEL = 2048
BATCH = 1
SEQ = 16384
DEPTH = 4
DEC_BATCH = 16
DEC_SEQ = 32
PAST_LEN = 4096

CHUNK = 64
D_MIX = D_MODEL
GROUP = D_MODEL // 16
N_POOL_G = 4
POOL_WINDOWS = (2, 4, 8, 16)
POOL_MAX = 16
D_POOL = N_POOL_G * GROUP
N_SGU_H = 6
D_SGU = N_SGU_H * GROUP
SGU_CHUNK = 128
N_CONV_G = 6
D_CONV = N_CONV_G * GROUP
CONV_K = 31
D_IN = D_POOL + 2 * D_SGU + 2 * D_CONV
SPLITS = (D_POOL, D_POOL + D_SGU, D_POOL + 2 * D_SGU, D_POOL + 2 * D_SGU + D_CONV)
D_FF = ((8 * D_MODEL // 3 + 255) // 256) * 256
EPS = 1e-6

kernel_name = 'hybrid_pool_sgu_conformer_stream_step'


def rms_norm(x, g):
    xf = x.astype(jnp.float32)
    y = xf * lax.rsqrt(jnp.mean(xf * xf, axis=-1, keepdims=True) + EPS)
    return (y * g.astype(jnp.float32)).astype(x.dtype)


def layer_norm(x, g, b):
    xf = x.astype(jnp.float32)
    mu = jnp.mean(xf, axis=-1, keepdims=True)
    xc = xf - mu
    y = xc * lax.rsqrt(jnp.mean(xc * xc, axis=-1, keepdims=True) + EPS)
    return (y * g.astype(jnp.float32) + b.astype(jnp.float32)).astype(x.dtype)


def swiglu(x, wg, wu, wd):
    return (jax.nn.silu(x @ wg) * (x @ wu)) @ wd


def pool_mixer(p, hist, pos0, pool_w, pool_scale):
    B, T, _ = p.shape
    H = hist.shape[1]
    seq = jnp.concatenate([hist, p], axis=1)
    padded = jnp.pad(seq.astype(jnp.float32), ((0, 0), (POOL_MAX, 0), (0, 0)))
    cs = jnp.cumsum(padded, axis=1)
    end = POOL_MAX + H
    cs_now = cs[:, end:end + T]
    pos = pos0 + jnp.arange(T)
    parts = []
    for g, w in enumerate(POOL_WINDOWS):
        sl = slice(g * GROUP, (g + 1) * GROUP)
        s = cs_now[..., sl] - cs[:, end - w:end - w + T, sl]
        cnt = jnp.minimum(w, pos + 1).astype(jnp.float32)[None, :, None]
        parts.append(s / cnt)
    pooled = jnp.concatenate(parts, axis=-1) - p.astype(jnp.float32)
    pooled = pooled.astype(p.dtype).reshape(B, T, N_POOL_G, GROUP)
    out = jnp.einsum('btgc,gcd->btgd', pooled, pool_w).reshape(B, T, D_POOL)
    return out * pool_scale, seq[:, -(POOL_MAX - 1):]


def sgu_mixer(u, v, sgu_w, sgu_b):
    B, T, _ = u.shape
    L = min(T, SGU_CHUNK)
    mask = jnp.tril(jnp.ones((L, L), dtype=bool))
    w = jnp.where(mask, sgu_w[:, :L, :L], 0)
    vb = v.reshape(B, T // L, L, N_SGU_H, GROUP)
    s = jnp.einsum('hqk,bnkhc->bnqhc', w, vb) + sgu_b[:, :L].T[None, None, :, :, None]
    return u * s.reshape(B, T, D_SGU)


def conv_mixer(za, zg, hist, conv_w, conv_b, ln_g, ln_b):
    c = za * jax.nn.sigmoid(zg)
    seq = jnp.concatenate([hist, c], axis=1)
    y = lax.conv_general_dilated(seq, conv_w[:, None, :], window_strides=(1,), padding='VALID',
                                 dimension_numbers=('NWC', 'WIO', 'NWC'),
                                 feature_group_count=D_CONV) + conv_b
    y = jax.nn.silu(layer_norm(y, ln_g, ln_b))
    return y, seq[:, -(CONV_K - 1):]


def layer(x, pool_hist, conv_hist, pos0, ng, wg, wu, wd, w_in_l, pool_w_l, pool_scale_l,
          sgu_g_l, sgu_w_l, sgu_b_l, conv_w_l, conv_b_l, ln_g_l, ln_b_l, w_out_l):
    x = x + 0.5 * rms_norm(swiglu(rms_norm(x, ng[0]), wg[0], wu[0], wd[0]), ng[1])
    h = rms_norm(x, ng[2])
    z = h @ w_in_l
    p, zu, zv, za, zg = jnp.split(z, SPLITS, axis=-1)
    y_pool, new_pool = pool_mixer(p, pool_hist, pos0, pool_w_l, pool_scale_l)
    u = jax.nn.gelu(zu, approximate=False)
    v = rms_norm(jax.nn.gelu(zv, approximate=False), sgu_g_l)
    y_sgu = sgu_mixer(u, v, sgu_w_l, sgu_b_l)
    y_conv, new_conv = conv_mixer(za, zg, conv_hist, conv_w_l, conv_b_l, ln_g_l, ln_b_l)
    m = jnp.concatenate([y_pool, y_sgu, y_conv], axis=-1) @ w_out_l
    x = x + rms_norm(m, ng[3])
    x = x + 0.5 * rms_norm(swiglu(rms_norm(x, ng[4]), wg[1], wu[1], wd[1]), ng[5])
    return x, new_pool, new_conv, v


def setup_inputs(seed: int = 0) -> dict:
    key = jax.random.key(seed)
    ks = jax.random.split(key, 19)

    def nrm(k, shape, s):
        return jax.random.normal(k, shape, jnp.float32) * s

    return {
        'x_prompt': nrm(ks[0], (BATCH, SEQ, D_MODEL), 1.0),
        'x_sample': nrm(ks[1], (DEC_BATCH, DEC_SEQ, D_MODEL), 1.0),
        'state_pool': nrm(ks[2], (DEPTH, DEC_BATCH, POOL_MAX - 1, D_POOL), 1.0),
        'state_conv': nrm(ks[3], (DEPTH, DEC_BATCH, CONV_K - 1, D_CONV), 0.5),
        'norm_g': 1.0 + nrm(ks[4], (DEPTH, 6, D_MODEL), 0.05),
        'ffn_w_gate': nrm(ks[5], (DEPTH, 2, D_MODEL, D_FF), D_MODEL ** -0.5),
        'ffn_w_up': nrm(ks[6], (DEPTH, 2, D_MODEL, D_FF), D_MODEL ** -0.5),
        'ffn_w_down': nrm(ks[7], (DEPTH, 2, D_FF, D_MODEL), D_FF ** -0.5),
        'w_in': nrm(ks[8], (DEPTH, D_MODEL, D_IN), D_MODEL ** -0.5),
        'pool_w': nrm(ks[9], (DEPTH, N_POOL_G, GROUP, GROUP), GROUP ** -0.5),
        'pool_scale': 1.0 + nrm(ks[10], (DEPTH, D_POOL), 0.1),
        'sgu_norm_g': 1.0 + nrm(ks[11], (DEPTH, D_SGU), 0.05),
        'sgu_w': nrm(ks[12], (DEPTH, N_SGU_H, SGU_CHUNK, SGU_CHUNK), SGU_CHUNK ** -0.5),
        'sgu_b': 1.0 + nrm(ks[13], (DEPTH, N_SGU_H, SGU_CHUNK), 0.1),
        'conv_w': nrm(ks[14], (DEPTH, CONV_K, D_CONV), CONV_K ** -0.5),
        'conv_b': nrm(ks[15], (DEPTH, D_CONV), 0.02),
        'conv_ln_g': 1.0 + nrm(ks[16], (DEPTH, D_CONV), 0.05),
        'conv_ln_b': nrm(ks[17], (DEPTH, D_CONV), 0.02),
        'w_out': nrm(ks[18], (DEPTH, D_MIX, D_MODEL), D_MIX ** -0.5),
    }


def reference(x_prompt, x_sample, state_pool, state_conv, norm_g, ffn_w_gate, ffn_w_up, ffn_w_down,
              w_in, pool_w, pool_scale, sgu_norm_g, sgu_w, sgu_b, conv_w, conv_b, conv_ln_g, conv_ln_b,
              w_out):
    yp = x_prompt
    ys = x_sample
    bp = x_prompt.shape[0]
    pool_p, conv_p, pool_s, conv_s, v_s = [], [], [], [], []
    for l in range(DEPTH):
        lw = (norm_g[l], ffn_w_gate[l], ffn_w_up[l], ffn_w_down[l], w_in[l], pool_w[l], pool_scale[l],
              sgu_norm_g[l], sgu_w[l], sgu_b[l], conv_w[l], conv_b[l], conv_ln_g[l], conv_ln_b[l], w_out[l])
        yp, pp, cp, _ = layer(yp, jnp.zeros((bp, 0, D_POOL), yp.dtype),
                              jnp.zeros((bp, CONV_K - 1, D_CONV), yp.dtype), 0, *lw)
        ys, ps, cs, vs = layer(ys, state_pool[l], state_conv[l], PAST_LEN, *lw)
        pool_p.append(pp)
        conv_p.append(cp)
        pool_s.append(ps)
        conv_s.append(cs)
        v_s.append(vs)
    new_pool_prompt = jnp.stack(pool_p)
    new_conv_prompt = jnp.stack(conv_p)
    new_pool_sample = jnp.stack(pool_s)
    new_conv_sample = jnp.stack(conv_s)
    new_sgu_v_sample = jnp.stack(v_s)
    return (yp, ys, new_pool_prompt, new_conv_prompt, new_pool_sample, new_conv_sample, new_sgu_v_sample)
```

```cpp
#include <hip/hip_runtime.h>
#include <cstdio>
#include <cstdint>
#define MK_MULTI 1
namespace pg8 {
#define PG8_LAS __attribute__((address_space(3)))
typedef unsigned short bf16_t;
typedef short bf16x8 __attribute__((ext_vector_type(8)));
typedef float f32x4 __attribute__((ext_vector_type(4)));
typedef unsigned u32x4 __attribute__((ext_vector_type(4)));
constexpr int BM = 256, BK = 64, HALF = 128, HTB = HALF * BK * 2  , STAGE_BYTES = 8 * HTB, NXCD = 8, WGM = 8;

__host__ __device__ __forceinline__ int lds_byte(int r, int c) { const int st = (r >> 4) * 2 + (c >> 5), rr = r & 15, cc = c & 31, ob = rr * 64 + cc * 2; return st * 1024 + (ob ^ (((ob >> 9) & 1) << 5)); }
__host__ __device__ __forceinline__ void stage_rc(int b, int& R, int& C) { const int st = b / 1024, sb = b % 1024, swz = sb ^ (((sb >> 9) & 1) << 5); R = (st >> 1) * 16 + swz / 64; C = (st & 1) * 32 + (swz % 64) / 2; }
__host__ __device__ __forceinline__ int perm32(int rho) { const int n = rho >> 4, i = rho & 15; return 8 * (i >> 2) + 4 * n + (i & 3); }

__device__ __forceinline__ int opaque_tid() { int t = threadIdx.x; asm volatile("" : "+v"(t)); return t; }
struct Unit { int pm, pn; };
struct Gemm { const bf16_t* A; const bf16_t* Bt; int M, N, K; };

struct StaticOrder {
    int nM, nN, nwg, G, c;
    __host__ __device__ void init(int M, int N, int G_, int c_) { nM = M / BM; nN = N / BM; nwg = nM * nN; G = G_; c = c_; }
    __host__ __device__ bool next(int i, Unit& u) const {
        const long L = (long)i * G + c; if (L >= nwg) return false;
        int wgid = (int)L; { const int q = nwg / NXCD, r = nwg % NXCD, xcd = wgid % NXCD, off = wgid / NXCD; wgid = (xcd < r ? xcd * (q + 1) : r * (q + 1) + (xcd - r) * q) + off; }
        const int nig = WGM * nN, gid = wgid / nig, fm = gid * WGM, gsz = (nM - fm) < WGM ? (nM - fm) : WGM;
        u.pm = fm + ((wgid % nig) % gsz); u.pn = (wgid % nig) / gsz; return true;
    }
    __device__ __forceinline__ void a_ready(const Unit&) const {}
    __device__ __forceinline__ void done(const Unit&) const {}
};
__device__ __forceinline__ unsigned cvt_pk_bf16(float lo, float hi) { unsigned r; asm volatile("v_cvt_pk_bf16_f32 %0, %1, %2" : "=v"(r) : "v"(lo), "v"(hi)); return r; }
typedef float f32x2 __attribute__((ext_vector_type(2)));
__device__ __forceinline__ f32x2 gelu_pk(f32x2 v) {
    const f32x2 av = __builtin_elementwise_abs(v), d = av * 0.2316418882f + 1.0f;
    f32x2 t; t.x = __builtin_amdgcn_rcpf(d.x); t.y = __builtin_amdgcn_rcpf(d.y);
    f32x2 q = t * 0.5307027145f + (-0.7265760135f); q = q * t + 0.7107068705f; q = q * t + (-0.142248368f); q = q * t + 0.127414796f; q = q * t;
    const f32x2 s = (v * v) * (-0.72134752044f);
    f32x2 e; e.x = __builtin_amdgcn_exp2f(s.x); e.y = __builtin_amdgcn_exp2f(s.y);
    const f32x2 m = v * (q * e), r = v - m;
    f32x2 o; o.x = v.x < 0.f ? m.x : r.x; o.y = v.y < 0.f ? m.y : r.y; return o;
}
__device__ __forceinline__ float sigmoid_f(float x) { return __builtin_amdgcn_rcpf(1.0f + __builtin_amdgcn_exp2f(x * -1.44269504089f)); }
struct EpiF32Y {
    static constexpr bool PERM = false, AFTER_DRAIN = false;
    float* C; int ldc;
    __device__ __forceinline__ void operator()(const f32x4 (&acc)[2][2][4][2], const Unit& u, int wr, int wc, int fr, int fq) const {
        const int row0 = u.pm * BM + wr * 64 + fr, col0 = u.pn * BM + wc * 32 + 4 * fq;
#pragma unroll
        for (int ai = 0; ai < 2; ++ai)
#pragma unroll
            for (int m = 0; m < 4; ++m) { float* rowp = C + (size_t)(row0 + ai * HALF + m * 16) * ldc + col0;
#pragma unroll
                for (int bj = 0; bj < 2; ++bj)
#pragma unroll
                    for (int n = 0; n < 2; ++n) *(f32x4*)(rowp + bj * HALF + n * 16) = acc[ai][bj][m][n]; }
    }
};
struct EpiSwiGLU {
    static constexpr bool PERM = true, AFTER_DRAIN = false;
    bf16_t* O; int ldc;
    __device__ __forceinline__ void operator()(const f32x4 (&acc)[2][2][4][2], const Unit& u, int wr, int wc, int fr, int fq) const {
        const int row0 = u.pm * BM + wr * 64 + fr, col0 = u.pn * HALF + wc * 32 + 8 * fq;
#pragma unroll
        for (int ai = 0; ai < 2; ++ai)
#pragma unroll
            for (int m = 0; m < 4; ++m) { bf16_t* rowp = O + (size_t)(row0 + ai * HALF + m * 16) * ldc + col0;
                float h[8];
#pragma unroll
                for (int n = 0; n < 2; ++n)
#pragma unroll
                    for (int j = 0; j < 4; ++j) { const float g = acc[ai][0][m][n][j], up = acc[ai][1][m][n][j]; h[4 * n + j] = g * sigmoid_f(g) * up; }
                u32x4 w; w.x = cvt_pk_bf16(h[0], h[1]); w.y = cvt_pk_bf16(h[2], h[3]); w.z = cvt_pk_bf16(h[4], h[5]); w.w = cvt_pk_bf16(h[6], h[7]);
                *(u32x4*)rowp = w; }
    }
};
struct EpiWin {
    static constexpr bool PERM = true, AFTER_DRAIN = false;
    bf16_t* Z; int ldc; float* rowstat;
    __device__ __forceinline__ void operator()(const f32x4 (&acc)[2][2][4][2], const Unit& u, int wr, int wc, int fr, int fq) const {
        const int row0 = u.pm * BM + wr * 64 + fr; const int pn = u.pn;
        if (pn < 8) {
            const int col0 = pn * BM + wc * 32 + 8 * fq; const bool act = pn >= 2, stat = pn >= 5;
#pragma unroll
            for (int ai = 0; ai < 2; ++ai)
#pragma unroll
                for (int m = 0; m < 4; ++m) { const int row = row0 + ai * HALF + m * 16; bf16_t* rowp = Z + (size_t)row * ldc + col0; float ss = 0.f;
#pragma unroll
                    for (int bj = 0; bj < 2; ++bj) { f32x4 v0 = acc[ai][bj][m][0], v1 = acc[ai][bj][m][1];
                        if (act) { f32x2 a = gelu_pk((f32x2){v0[0], v0[1]}), b = gelu_pk((f32x2){v0[2], v0[3]}), c = gelu_pk((f32x2){v1[0], v1[1]}), d = gelu_pk((f32x2){v1[2], v1[3]});
                            v0 = (f32x4){a.x, a.y, b.x, b.y}; v1 = (f32x4){c.x, c.y, d.x, d.y}; }
                        ss += (v0[0] * v0[0] + v0[1] * v0[1]) + (v0[2] * v0[2] + v0[3] * v0[3]) + (v1[0] * v1[0] + v1[1] * v1[1]) + (v1[2] * v1[2] + v1[3] * v1[3]);
                        u32x4 w; w.x = cvt_pk_bf16(v0[0], v0[1]); w.y = cvt_pk_bf16(v0[2], v0[3]); w.z = cvt_pk_bf16(v1[0], v1[1]); w.w = cvt_pk_bf16(v1[2], v1[3]);
                        *(u32x4*)(rowp + bj * HALF) = w; }
                    if (stat) { ss += __shfl_xor(ss, 16); ss += __shfl_xor(ss, 32); if (fq == 0) rowstat[(size_t)row * 12 + (pn - 5) * 4 + wc] = ss; } }
        } else {
            const int col0 = 2048 + (pn - 8) * HALF + wc * 32 + 8 * fq;
#pragma unroll
            for (int ai = 0; ai < 2; ++ai)
#pragma unroll
                for (int m = 0; m < 4; ++m) { bf16_t* rowp = Z + (size_t)(row0 + ai * HALF + m * 16) * ldc + col0;
                    float h[8];
#pragma unroll
                    for (int n = 0; n < 2; ++n)
#pragma unroll
                        for (int j = 0; j < 4; ++j) h[4 * n + j] = acc[ai][0][m][n][j] * sigmoid_f(acc[ai][1][m][n][j]);
                    u32x4 w; w.x = cvt_pk_bf16(h[0], h[1]); w.y = cvt_pk_bf16(h[2], h[3]); w.z = cvt_pk_bf16(h[4], h[5]); w.w = cvt_pk_bf16(h[6], h[7]);
                    *(u32x4*)rowp = w; }
        }
    }
};
template <class Epi, class Sched, bool ALIGN_EPI = false, bool SP2 = false>
__device__ __forceinline__ void gemm_phase(PG8_LAS unsigned char* lds, const Gemm g, const Sched& S, const Epi& E) {
    const int tid = opaque_tid(), wid = __builtin_amdgcn_readfirstlane(tid >> 6), lane = tid & 63, wr = wid >> 2, wc = wid & 3, fr = lane & 15, fq = lane >> 4;
    const int K = g.K, nt = K / BK;
    unsigned voffA[2], voffB[2];
#pragma unroll
    for (int i = 0; i < 2; ++i) { int R, C; stage_rc(tid * 16 + i * 8192, R, C); const int Rb = Epi::PERM ? ((R & ~31) + perm32(R & 31)) : R;
        voffA[i] = (unsigned)(R * K + C) * 2u; voffB[i] = (unsigned)(Rb * K + C) * 2u; }
    const size_t kstep = (size_t)(BK * 2);
    const size_t hstep = (size_t)HALF * K * 2;
    const size_t tstep = 2 * hstep;
    const unsigned ldsw = (unsigned)wid * 1024u;
    const int aoff = lds_byte(wr * 64 + fr, fq * 8), boff = lds_byte(wc * 32 + fr, fq * 8);
#define PG8_SA(b, h) (((b) * 2 + (h)) * HTB)
#define PG8_SB(b, h) ((4 + (b) * 2 + (h)) * HTB)
#define PG8_STAGE(bufoff, gbase, voff) do { _Pragma("unroll") for (int _i = 0; _i < 2; ++_i) \
        __builtin_amdgcn_global_load_lds((const unsigned*)((const char*)(gbase) + (voff)[_i]), (PG8_LAS unsigned*)(lds + (bufoff) + ldsw + _i * 8192), 16, 0, 0); } while (0)
#define PG8_LDA(dst, b, h) do { _Pragma("unroll") for (int m = 0; m < 4; ++m) _Pragma("unroll") for (int k = 0; k < 2; ++k) dst[m][k] = *(const PG8_LAS bf16x8*)(lds + PG8_SA(b, h) + aoff + m * 2048 + k * 1024); } while (0)
#define PG8_LDB(dst, b, h) do { _Pragma("unroll") for (int n = 0; n < 2; ++n) _Pragma("unroll") for (int k = 0; k < 2; ++k) dst[n][k] = *(const PG8_LAS bf16x8*)(lds + PG8_SB(b, h) + boff + n * 2048 + k * 1024); } while (0)
#define PG8_MMA(ai, bj, At, Bt) do { __builtin_amdgcn_s_setprio(1); _Pragma("unroll") for (int m = 0; m < 4; ++m) _Pragma("unroll") for (int n = 0; n < 2; ++n) _Pragma("unroll") for (int k = 0; k < 2; ++k) \
        acc[ai][bj][m][n] = __builtin_amdgcn_mfma_f32_16x16x32_bf16(Bt[n][k], At[m][k], acc[ai][bj][m][n], 0, 0, 0); __builtin_amdgcn_s_setprio(0); } while (0)
#define PG8_WAIT_V(n) asm volatile("s_waitcnt vmcnt(" #n ")" ::: "memory")
#define PG8_WAIT_L(n) asm volatile("s_waitcnt lgkmcnt(" #n ")" ::: "memory")
#define PG8_BAR __builtin_amdgcn_s_barrier()
#define PG8_SCHED __builtin_amdgcn_sched_barrier(0)
    Unit cur, nxt; int ui = 0;
    if (!S.next(0, cur)) return;
    f32x4 acc[2][2][4][2];
#pragma unroll
    for (int a = 0; a < 2; ++a)
#pragma unroll
        for (int b = 0; b < 2; ++b)
#pragma unroll
            for (int m = 0; m < 4; ++m)
#pragma unroll
                for (int n = 0; n < 2; ++n) acc[a][b][m][n] = (f32x4){0.f, 0.f, 0.f, 0.f};
    bf16x8 At[4][2], B0[2][2], B1[2][2];
    const char* cA = (const char*)g.A + (size_t)cur.pm * tstep; const char* cB = (const char*)g.Bt + (size_t)cur.pn * tstep;
    S.a_ready(cur);
    if constexpr (SP2) {
        PG8_STAGE(PG8_SB(0, 0), cB, voffB); PG8_STAGE(PG8_SB(0, 1), cB + hstep, voffB); PG8_STAGE(PG8_SA(0, 0), cA, voffA); PG8_STAGE(PG8_SA(0, 1), cA + hstep, voffA);
        if (wr == 1) PG8_BAR;
        PG8_WAIT_V(2); PG8_BAR;
        PG8_STAGE(PG8_SB(1, 0), cB + kstep, voffB); PG8_STAGE(PG8_SA(1, 0), cA + kstep, voffA); PG8_STAGE(PG8_SB(1, 1), cB + hstep + kstep, voffB);
        PG8_WAIT_V(6); PG8_BAR;
    } else {
        PG8_STAGE(PG8_SB(0, 0), cB, voffB); PG8_STAGE(PG8_SA(0, 0), cA, voffA); PG8_STAGE(PG8_SB(0, 1), cB + hstep, voffB); PG8_STAGE(PG8_SA(0, 1), cA + hstep, voffA);
        if (wr == 1) PG8_BAR;
        PG8_WAIT_V(4); PG8_BAR;
        PG8_STAGE(PG8_SB(1, 0), cB + kstep, voffB); PG8_STAGE(PG8_SA(1, 0), cA + kstep, voffA); PG8_STAGE(PG8_SB(1, 1), cB + hstep + kstep, voffB);
        PG8_WAIT_V(6); PG8_BAR;
    }
    for (;;) {
        const bool has_next = S.next(ui + 1, nxt);
        const char* nA = has_next ? (const char*)g.A + (size_t)nxt.pm * tstep : cA; const char* nB = has_next ? (const char*)g.Bt + (size_t)nxt.pn * tstep : cB;
        for (int t = 0; t < nt; t += 2) {
            const bool last = (t == nt - 2);
            const char* a1 = cA + (size_t)(t + 1) * kstep;
            const char* a2 = last ? nA : cA + (size_t)(t + 2) * kstep; const char* b2 = last ? nB : cB + (size_t)(t + 2) * kstep;
            const char* a3 = a2 + kstep; const char* b3 = b2 + kstep;
            if (last && has_next) S.a_ready(nxt);
            if constexpr (SP2) {
            PG8_LDB(B0, 0, 0); PG8_LDB(B1, 0, 1); PG8_SCHED; PG8_LDA(At, 0, 0); PG8_STAGE(PG8_SA(1, 1), a1 + hstep, voffA);
            PG8_WAIT_V(8); PG8_WAIT_L(0); PG8_BAR; PG8_MMA(0, 0, At, B0); PG8_MMA(0, 1, At, B1); PG8_BAR; PG8_SCHED;
            PG8_LDA(At, 0, 1); PG8_STAGE(PG8_SB(0, 0), b2, voffB); PG8_STAGE(PG8_SB(0, 1), b2 + hstep, voffB); PG8_STAGE(PG8_SA(0, 0), a2, voffA);
            PG8_WAIT_V(8); PG8_WAIT_L(0); PG8_BAR; PG8_MMA(1, 0, At, B0); PG8_MMA(1, 1, At, B1); PG8_BAR; PG8_SCHED;
            PG8_LDB(B0, 1, 0); PG8_LDB(B1, 1, 1); PG8_SCHED; PG8_LDA(At, 1, 0); PG8_STAGE(PG8_SA(0, 1), a2 + hstep, voffA);
            PG8_WAIT_V(8); PG8_WAIT_L(0); PG8_BAR; PG8_MMA(0, 0, At, B0); PG8_MMA(0, 1, At, B1); PG8_BAR; PG8_SCHED;
            PG8_LDA(At, 1, 1); PG8_STAGE(PG8_SB(1, 0), b3, voffB); PG8_STAGE(PG8_SB(1, 1), b3 + hstep, voffB); PG8_STAGE(PG8_SA(1, 0), a3, voffA);
            PG8_WAIT_V(8); PG8_WAIT_L(0); PG8_BAR; PG8_MMA(1, 0, At, B0); PG8_MMA(1, 1, At, B1); PG8_BAR; PG8_SCHED;
            } else {
            PG8_LDB(B0, 0, 0); PG8_SCHED; PG8_LDA(At, 0, 0); PG8_STAGE(PG8_SA(1, 1), a1 + hstep, voffA);
            PG8_WAIT_L(8); PG8_BAR; PG8_WAIT_L(0); PG8_MMA(0, 0, At, B0); PG8_BAR; PG8_SCHED;
            PG8_LDB(B1, 0, 1); PG8_STAGE(PG8_SB(0, 0), b2, voffB);
            PG8_BAR; PG8_WAIT_L(0); PG8_MMA(0, 1, At, B1); PG8_BAR;
            PG8_LDA(At, 0, 1); PG8_STAGE(PG8_SA(0, 0), a2, voffA);
            PG8_BAR; PG8_WAIT_L(0); PG8_MMA(1, 0, At, B0); PG8_BAR; PG8_SCHED;
            PG8_STAGE(PG8_SB(0, 1), b2 + hstep, voffB);
            PG8_WAIT_V(6); PG8_BAR; PG8_MMA(1, 1, At, B1); PG8_BAR;
            PG8_LDB(B0, 1, 0); PG8_SCHED; PG8_LDA(At, 1, 0); PG8_STAGE(PG8_SA(0, 1), a2 + hstep, voffA);
            PG8_WAIT_L(8); PG8_BAR; PG8_WAIT_L(0); PG8_MMA(0, 0, At, B0); PG8_BAR; PG8_SCHED;
            PG8_LDB(B1, 1, 1); PG8_STAGE(PG8_SB(1, 0), b3, voffB);
            PG8_BAR; PG8_WAIT_L(0); PG8_MMA(0, 1, At, B1); PG8_BAR;
            PG8_LDA(At, 1, 1); PG8_STAGE(PG8_SA(1, 0), a3, voffA);
            PG8_BAR; PG8_WAIT_L(0); PG8_MMA(1, 0, At, B0); PG8_BAR; PG8_SCHED;
            PG8_STAGE(PG8_SB(1, 1), b3 + hstep, voffB);
            PG8_WAIT_V(6); PG8_BAR; PG8_MMA(1, 1, At, B1); PG8_BAR;
            }
        }
        if constexpr (ALIGN_EPI) { if (wr == 0) PG8_BAR; }
        if constexpr (!Epi::AFTER_DRAIN) { E(acc, cur, wr, wc, fr, fq); S.done(cur); }
        if (!has_next) break;
#pragma unroll
        for (int a = 0; a < 2; ++a)
#pragma unroll
            for (int b = 0; b < 2; ++b)
#pragma unroll
                for (int m = 0; m < 4; ++m)
#pragma unroll
                    for (int n = 0; n < 2; ++n) acc[a][b][m][n] = (f32x4){0.f, 0.f, 0.f, 0.f};
        cur = nxt; cA = nA; cB = nB; ++ui;
        if constexpr (ALIGN_EPI) { if (wr == 1) PG8_BAR; }
    }
    PG8_WAIT_V(0);
    if constexpr (!ALIGN_EPI) { if (wr == 0) PG8_BAR; }
    PG8_BAR;
    if constexpr (Epi::AFTER_DRAIN) { E.fused(acc, cur, wr, wc, fr, fq, lds, wid, lane); S.done(cur); }
#undef PG8_SA
#undef PG8_SB
#undef PG8_STAGE
#undef PG8_LDA
#undef PG8_LDB
#undef PG8_MMA
#undef PG8_WAIT_V
#undef PG8_WAIT_L
#undef PG8_BAR
#undef PG8_SCHED
}
}
#define GAS __attribute__((address_space(1)))
#define LAS __attribute__((address_space(3)))
typedef unsigned short bf16;
typedef unsigned v4u __attribute__((ext_vector_type(4)));
typedef float f32x4 __attribute__((ext_vector_type(4)));
typedef short bf16x8 __attribute__((ext_vector_type(8)));
typedef GAS unsigned gu32;
typedef GAS unsigned long long gu64;
#define RLX_AGENT __ATOMIC_RELAXED, __HIP_MEMORY_SCOPE_AGENT
#define LDS_WAIT() asm volatile("s_waitcnt lgkmcnt(0)" ::: "memory")
#define VM_WAIT() asm volatile("s_waitcnt vmcnt(0)" ::: "memory")
__device__ __forceinline__ unsigned long long rt() { return __builtin_amdgcn_s_memrealtime(); }
__device__ __forceinline__ unsigned f2bf(float f) { unsigned u = __builtin_bit_cast(unsigned, f); return (u + 0x7fffu + ((u >> 16) & 1u)) >> 16; }
__device__ __forceinline__ unsigned pk2(float lo, float hi) { return f2bf(lo) | (f2bf(hi) << 16); }

#define XB_TMO      128
#define XB_XCNT(j)  (256  + 64 * (j))
#define XB_XSUB(j)  (1280 + 64 * (j))
#define XB_XGEN(j)  (2304 + 64 * (j))
#define XB_TOP      3328
#define XB_TOPGEN   3392
#define XCD_BAR_WORDS 3456
#define XB_SPIN_CAP (1u << 18)

__device__ __forceinline__ unsigned xb_ld(unsigned* p)              { return __hip_atomic_load(p, __ATOMIC_RELAXED, __HIP_MEMORY_SCOPE_AGENT); }
__device__ __forceinline__ unsigned xb_add(unsigned* p, unsigned v) { return __hip_atomic_fetch_add(p, v, __ATOMIC_RELAXED, __HIP_MEMORY_SCOPE_AGENT); }
__device__ __forceinline__ unsigned xb_xcc_id() { return (unsigned)__builtin_amdgcn_s_getreg((3 << 11) | 20) & 0xFu; }
#define XB_SPIN(cond, bar) do { unsigned _sp = 0; while (cond) { __builtin_amdgcn_s_sleep(1); \
    if ((++_sp & 255u) == 0u) { if (xb_ld(&(bar)[XB_TMO])) break; if (_sp > XB_SPIN_CAP) { atomicAdd(&(bar)[XB_TMO], 1u); break; } } } } while (0)

struct XcdBarrier {
    unsigned* bar; unsigned x;
    volatile LAS unsigned* st;
};

__device__ __forceinline__ XcdBarrier xcd_barrier_post(unsigned* bar, volatile LAS unsigned* st) {
    XcdBarrier b; b.bar = bar; b.x = xb_xcc_id(); b.st = st;
    if (threadIdx.x == 0) (void)xb_add(&bar[XB_XCNT(b.x)], 1u);
    return b;
}
__device__ __forceinline__ void xcd_barrier_complete(unsigned* bar, unsigned x, unsigned& nloc, unsigned& nx) {
    const unsigned G = gridDim.x * gridDim.y * gridDim.z;
    unsigned sum, cnt, mine, sp = 0u;
    for (;;) {
        sum = 0u; cnt = 0u; mine = 0u;
#pragma unroll
        for (unsigned j = 0; j < 16; ++j) { const unsigned c = xb_ld(&bar[XB_XCNT(j)]); sum += c; cnt += (c > 0u) ? 1u : 0u; mine = (j == x) ? c : mine; }
        if (sum == G) break;
        __builtin_amdgcn_s_sleep(1);
        if ((++sp & 255u) == 0u) { if (xb_ld(&bar[XB_TMO])) break; if (sp > XB_SPIN_CAP) { atomicAdd(&bar[XB_TMO], 1u); break; } }
    }
    nloc = mine > 0u ? mine : 1u; nx = cnt > 0u ? cnt : 1u;
}

__device__ __forceinline__ void xcd_barrier(const XcdBarrier& b) {
    asm volatile("s_waitcnt vmcnt(0)" ::: "memory");
    __syncthreads();
    if (threadIdx.x == 0) {
        unsigned* bar = b.bar;
        __builtin_amdgcn_s_waitcnt(0);
        unsigned nloc = b.st[0], nx = b.st[1];
        if (nloc == 0u) { xcd_barrier_complete(bar, b.x, nloc, nx); b.st[0] = nloc; b.st[1] = nx; }
        const unsigned old = xb_add(&bar[XB_XSUB(b.x)], 1u);
        const unsigned gen = old / nloc;
        if (old + 1u == (gen + 1u) * nloc) {
            __builtin_amdgcn_fence(__ATOMIC_RELEASE, "agent");
            asm volatile("s_waitcnt vmcnt(0)" ::: "memory");
            const unsigned og = xb_add(&bar[XB_TOP], 1u);
            const unsigned tg = og / nx;
            if (og + 1u == (tg + 1u) * nx) xb_add(&bar[XB_TOPGEN], 1u);
            else XB_SPIN(xb_ld(&bar[XB_TOPGEN]) == tg, bar);
            __builtin_amdgcn_fence(__ATOMIC_ACQUIRE, "agent");
            xb_add(&bar[XB_XGEN(b.x)], 1u);
            asm volatile("s_waitcnt vmcnt(0)" ::: "memory");
        } else {
            XB_SPIN(xb_ld(&bar[XB_XGEN(b.x)]) == gen, bar);
            __builtin_amdgcn_fence(__ATOMIC_ACQUIRE, "agent");
            asm volatile("s_waitcnt vmcnt(0)" ::: "memory");
        }
    }
    __syncthreads();
}
constexpr int NWAVES = 8;
constexpr int DM = 2048, SEQ = 16384, DEPTH = 4, DEC_B = 16, DEC_T = 32, MS = DEC_B * DEC_T, M = SEQ + MS;
constexpr int DFF = 5632, DIN = 3584, DPOOL = 512, DSGU = 768, DCONV = 768, CONVK = 31, ZP = 2816;
constexpr int NGU = 2 * DFF;
constexpr float EPS = 1e-6f;
#ifndef MK_MULTI
#define MK_MULTI 0
#endif
constexpr int NPHASE = 1 + 10 * DEPTH;
constexpr size_t O_Y = 0, O_POOLP = (size_t)M * DM, O_CONVP = O_POOLP + (size_t)DEPTH * 15 * DPOOL, O_POOLS = O_CONVP + (size_t)DEPTH * 30 * DCONV,
                 O_CONVS = O_POOLS + (size_t)DEPTH * DEC_B * 15 * DPOOL, O_V = O_CONVS + (size_t)DEPTH * DEC_B * 30 * DCONV, O_END = O_V + (size_t)DEPTH * DEC_B * DEC_T * DSGU;
constexpr size_t MiB = 1u << 20;
constexpr size_t WS_CTL = 0, CTL_ZERO_BYTES = 1 * MiB;
constexpr size_t WS_PWT = 1 * MiB;
constexpr size_t WS_SGA = WS_PWT + 512 * 1024;
constexpr size_t WS_SGAS = WS_SGA + 768 * 1024;
constexpr size_t WS_ROWSTAT = 4 * MiB;
constexpr size_t WS_W = 8 * MiB;
constexpr size_t WL_GU1 = 0, WL_D1 = (size_t)NGU * DM, WL_IN = WL_D1 + (size_t)DM * DFF, WL_OUT = WL_IN + (size_t)DIN * DM, WL_GU2 = WL_OUT + (size_t)DM * DM,
                 WL_D2 = WL_GU2 + (size_t)NGU * DM, WL_TOTAL = WL_D2 + (size_t)DM * DFF;
constexpr size_t WS_H = 624 * MiB;
constexpr size_t WS_CAT = 690 * MiB;
constexpr size_t WS_Y = 756 * MiB;
constexpr size_t WS_HID = 888 * MiB;
constexpr size_t WS_Z = WS_HID;
constexpr size_t WS_END = 1070 * MiB;
static_assert(WS_W + 4 * WL_TOTAL * 2 <= WS_H && WS_H + (size_t)M * DM * 2 <= WS_CAT && WS_CAT + (size_t)M * DM * 2 <= WS_Y && WS_Y + (size_t)M * DM * 4 <= WS_HID && WS_HID + (size_t)M * DFF * 2 <= WS_END, "ws map");
static_assert(WS_ROWSTAT + (size_t)M * 12 * 4 <= WS_W && WS_SGAS + 768 * 1024 <= WS_ROWSTAT, "ws map small");
constexpr int CW_TMO = 0, CW_BAR = 4096;
constexpr int RING_OFF = 0, RING_BYTES = 131072, LDSCTL_OFF = RING_BYTES, MISC_OFF = LDSCTL_OFF + 320, LDS_BYTES = 147456;
constexpr int HTB = pg8::HTB;

typedef float f32x2 __attribute__((ext_vector_type(2)));
typedef unsigned u32x2 __attribute__((ext_vector_type(2)));
__device__ __forceinline__ float bf2f(unsigned short b) { return __builtin_bit_cast(float, (unsigned)b << 16); }
__device__ __forceinline__ float bflo(unsigned u) { return __builtin_bit_cast(float, u << 16); }
__device__ __forceinline__ float bfhi(unsigned u) { return __builtin_bit_cast(float, u & 0xffff0000u); }
__device__ __forceinline__ float wave_sum(float v) {
#pragma unroll
    for (int o = 1; o < 64; o <<= 1) v += __shfl_xor(v, o);
    return v;
}

struct Args { const float* in[19]; float* out; unsigned char* ws; int ph_lo, ph_hi; };
struct Frame { LAS unsigned char* lds; volatile LAS unsigned* MISC; gu32* ctl; int vcu, G; };
struct Tid { int tid, lane, wave; };
__device__ __forceinline__ Tid get_tid() { Tid t; t.tid = pg8::opaque_tid(); t.lane = t.tid & 63; t.wave = __builtin_amdgcn_readfirstlane(t.tid >> 6); return t; }

__device__ __forceinline__ void cvt_item(const float* src, int N, int k0, int n0, bf16* dst, int K, int drow0, LAS unsigned short* scr, int lane) {
    f32x4 v[16];
    const float* s = src + (size_t)(k0 + (lane >> 4)) * N + n0 + 4 * (lane & 15);
#pragma unroll
    for (int i = 0; i < 16; ++i) v[i] = *(const f32x4*)(s + (size_t)(4 * i) * N);
#pragma unroll
    for (int i = 0; i < 16; ++i) { const int kl = 4 * i + (lane >> 4), nl = 4 * (lane & 15);
#pragma unroll
        for (int j = 0; j < 4; ++j) scr[(nl + j) * 72 + kl] = (unsigned short)f2bf(v[i][j]); }
    LDS_WAIT(); asm volatile("" ::: "memory");
#pragma unroll
    for (int j = 0; j < 8; ++j) { const int nl = (lane >> 3) + 8 * j, c = lane & 7;
        const v4u o = *(const LAS v4u*)(scr + nl * 72 + 8 * c);
        *(v4u*)(dst + (size_t)(drow0 + nl) * K + k0 + 8 * c) = o; }
    LDS_WAIT(); asm volatile("" ::: "memory");
}
__device__ __forceinline__ void convert_weights(const Frame& F, const Args& a) {
    const Tid t = get_tid();
    LAS unsigned short* scr = (LAS unsigned short*)(F.lds + RING_OFF + t.wave * 9216);
    const int gw = F.vcu * NWAVES + t.wave, NGW = F.G * NWAVES;
    constexpr int IPL = 19712;
    bf16* Wb = (bf16*)(a.ws + WS_W);
    for (int it = gw; it < IPL * DEPTH; it += NGW) {
        const int l = it / IPL; int r = it % IPL; bf16* wl = Wb + (size_t)l * WL_TOTAL;
        const float* src; int N, K; bf16* dst; int kind;
        if (r < 2816)       { src = a.in[5] + (size_t)(l * 2 + 0) * DM * DFF; N = DFF; K = DM; dst = wl + WL_GU1; kind = 1; }
        else if (r < 5632)  { r -= 2816;  src = a.in[6] + (size_t)(l * 2 + 0) * DM * DFF; N = DFF; K = DM; dst = wl + WL_GU1; kind = 2; }
        else if (r < 8448)  { r -= 5632;  src = a.in[7] + (size_t)(l * 2 + 0) * DFF * DM; N = DM; K = DFF; dst = wl + WL_D1; kind = 0; }
        else if (r < 10240) { r -= 8448;  src = a.in[8] + (size_t)l * DM * DIN; N = DIN; K = DM; dst = wl + WL_IN; kind = 3; }
        else if (r < 11264) { r -= 10240; src = a.in[18] + (size_t)l * DM * DM; N = DM; K = DM; dst = wl + WL_OUT; kind = 0; }
        else if (r < 14080) { r -= 11264; src = a.in[5] + (size_t)(l * 2 + 1) * DM * DFF; N = DFF; K = DM; dst = wl + WL_GU2; kind = 1; }
        else if (r < 16896) { r -= 14080; src = a.in[6] + (size_t)(l * 2 + 1) * DM * DFF; N = DFF; K = DM; dst = wl + WL_GU2; kind = 2; }
        else                { r -= 16896; src = a.in[7] + (size_t)(l * 2 + 1) * DFF * DM; N = DM; K = DFF; dst = wl + WL_D2; kind = 0; }
        const int nb = N >> 6, kb = r / nb, cb = r % nb, n0 = cb * 64; int drow0 = n0;
        if (kind == 1) drow0 = 256 * (n0 >> 7) + (n0 & 127);
        else if (kind == 2) drow0 = 256 * (n0 >> 7) + 128 + (n0 & 127);
        else if (kind == 3) { if (n0 >= 2816) drow0 = 2048 + 256 * ((n0 - 2816) >> 7) + 128 + ((n0 - 2816) & 127); else if (n0 >= 2048) drow0 = 2048 + 256 * ((n0 - 2048) >> 7) + ((n0 - 2048) & 127); }
        cvt_item(src, N, kb * 64, n0, dst, K, drow0, scr, t.lane);
    }
}
__device__ __forceinline__ void convert_small(const Frame& F, const Args& a) {
    const Tid t = get_tid();
    const int gt = F.vcu * (NWAVES * 64) + t.tid, NGT = F.G * NWAVES * 64;
    bf16* pwt = (bf16*)(a.ws + WS_PWT); bf16* sga = (bf16*)(a.ws + WS_SGA); bf16* sgas = (bf16*)(a.ws + WS_SGAS);
    for (int e = gt; e < DEPTH * 4 * 16384; e += NGT) { const int c = e & 127, d = (e >> 7) & 127, lg = e >> 14; pwt[e] = (bf16)f2bf(a.in[9][(size_t)lg * 16384 + c * 128 + d]); }
    for (int e = gt; e < DEPTH * 6 * 16384; e += NGT) { const int k = e & 127, q = (e >> 7) & 127, lh = e >> 14;
        sga[e] = (bf16)(k <= q ? f2bf(a.in[12][e]) : 0u);
        const int bq = q >> 5, qq = q & 31, bk = k >> 5, kk = k & 31;
        sgas[e] = (bf16)((bq == bk && kk <= qq) ? f2bf(a.in[12][(size_t)lh * 16384 + qq * 128 + kk]) : 0u); }
}

template <int MODE> __device__ __forceinline__ void norm_phase(const Frame& F, const Args& a, const float* gpost, float scale, const float* gpre) {
    const Tid t = get_tid(); const int lane = t.lane;
    const int gw = F.vcu * NWAVES + t.wave, NGW = F.G * NWAVES;
    float* X = a.out + O_Y; const float* Y = (const float*)(a.ws + WS_Y); bf16* H = (bf16*)(a.ws + WS_H);
    f32x4 gp[8], gq[8];
#pragma unroll
    for (int j = 0; j < 8; ++j) { if (MODE != 0) gp[j] = *((const f32x4*)gpost + lane + 64 * j); if (MODE != 2) gq[j] = *((const f32x4*)gpre + lane + 64 * j); }
    for (int m = gw; m < M; m += NGW) {
        f32x4 xv[8];
        if (MODE == 0) { const float* src = m < SEQ ? a.in[0] + (size_t)m * DM : a.in[1] + (size_t)(m - SEQ) * DM;
#pragma unroll
            for (int j = 0; j < 8; ++j) xv[j] = *((const f32x4*)src + lane + 64 * j);
        } else {
            f32x4 yv[8]; float s = 0.f;
#pragma unroll
            for (int j = 0; j < 8; ++j) { yv[j] = *((const f32x4*)(Y + (size_t)m * DM) + lane + 64 * j); xv[j] = *((const f32x4*)(X + (size_t)m * DM) + lane + 64 * j); }
#pragma unroll
            for (int j = 0; j < 8; ++j) s += (yv[j][0] * yv[j][0] + yv[j][1] * yv[j][1]) + (yv[j][2] * yv[j][2] + yv[j][3] * yv[j][3]);
            const float r = scale / sqrtf(wave_sum(s) * (1.0f / DM) + EPS);
#pragma unroll
            for (int j = 0; j < 8; ++j) xv[j] = xv[j] + (yv[j] * r) * gp[j];
        }
#pragma unroll
        for (int j = 0; j < 8; ++j) *((f32x4*)(X + (size_t)m * DM) + lane + 64 * j) = xv[j];
        if (MODE != 2) {
            float s2 = 0.f;
#pragma unroll
            for (int j = 0; j < 8; ++j) s2 += (xv[j][0] * xv[j][0] + xv[j][1] * xv[j][1]) + (xv[j][2] * xv[j][2] + xv[j][3] * xv[j][3]);
            const float r2 = 1.0f / sqrtf(wave_sum(s2) * (1.0f / DM) + EPS);
#pragma unroll
            for (int j = 0; j < 8; ++j) { const f32x4 o = (xv[j] * r2) * gq[j]; u32x2 w; w.x = pg8::cvt_pk_bf16(o[0], o[1]); w.y = pg8::cvt_pk_bf16(o[2], o[3]);
                *((u32x2*)(H + (size_t)m * DM) + lane + 64 * j) = w; }
        }
    }
}

__device__ __forceinline__ void quad_mma(LAS unsigned char* la, LAS unsigned char* lb, int wr, int wc, int fr, int fq, f32x4 (&acc)[4][2]) {
    const int aoff = pg8::lds_byte(wr * 64 + fr, fq * 8), boff = pg8::lds_byte(wc * 32 + fr, fq * 8);
#pragma unroll
    for (int m = 0; m < 4; ++m)
#pragma unroll
        for (int n = 0; n < 2; ++n) acc[m][n] = (f32x4){0.f, 0.f, 0.f, 0.f};
#pragma unroll
    for (int kb = 0; kb < 2; ++kb) {
        bf16x8 At[4][2], Bf[2][2];
#pragma unroll
        for (int m = 0; m < 4; ++m)
#pragma unroll
            for (int k = 0; k < 2; ++k) At[m][k] = *(const LAS bf16x8*)(la + kb * HTB + aoff + m * 2048 + k * 1024);
#pragma unroll
        for (int n = 0; n < 2; ++n)
#pragma unroll
            for (int k = 0; k < 2; ++k) Bf[n][k] = *(const LAS bf16x8*)(lb + kb * HTB + boff + n * 2048 + k * 1024);
#pragma unroll
        for (int m = 0; m < 4; ++m)
#pragma unroll
            for (int n = 0; n < 2; ++n)
#pragma unroll
                for (int k = 0; k < 2; ++k) acc[m][n] = __builtin_amdgcn_mfma_f32_16x16x32_bf16(Bf[n][k], At[m][k], acc[m][n], 0, 0, 0);
    }
}
__device__ __forceinline__ void stage_image(const bf16* src, LAS unsigned char* img, int tid) {
#pragma unroll
    for (int kb = 0; kb < 2; ++kb)
#pragma unroll
        for (int i = 0; i < 2; ++i) { const int b = tid * 16 + i * 8192; int R, C; pg8::stage_rc(b, R, C);
            *(LAS v4u*)(img + kb * HTB + b) = *(const v4u*)(src + R * 128 + kb * 64 + C); }
}

__device__ __forceinline__ void pool_unit(const Frame& F, const Args& a, int l, int T, int g) {
    LAS unsigned short* PB = (LAS unsigned short*)(F.lds + 0);
    LAS unsigned char* LA = F.lds + 49152; LAS unsigned char* LB = F.lds + 81920;
    const bf16* Z = (const bf16*)(a.ws + WS_Z); bf16* CAT = (bf16*)(a.ws + WS_CAT);
    const Tid t = get_tid(); const int r0 = 128 * T; const bool sample = r0 >= SEQ; const int tid = t.tid;
    __syncthreads();
    stage_image((const bf16*)(a.ws + WS_PWT) + (size_t)(l * 4 + g) * 16384, LB, tid);
    for (int it = tid; it < 4 * 47 * 16; it += NWAVES * 64) {
        const int seg = it / 752, rem = it % 752, rr = rem >> 4, ch = rem & 15;
        v4u val = (v4u){0u, 0u, 0u, 0u};
        if (sample && rr < 15) { const int b = ((r0 - SEQ) >> 5) + seg; const float* s = a.in[2] + ((size_t)(l * DEC_B + b) * 15 + rr) * DPOOL + g * 128 + 8 * ch;
            const f32x4 p0 = *(const f32x4*)s, p1 = *(const f32x4*)(s + 4);
            val.x = pg8::cvt_pk_bf16(p0[0], p0[1]); val.y = pg8::cvt_pk_bf16(p0[2], p0[3]); val.z = pg8::cvt_pk_bf16(p1[0], p1[1]); val.w = pg8::cvt_pk_bf16(p1[2], p1[3]);
        } else { const int row = r0 + 32 * seg + rr - 15; if (row >= 0) val = *(const v4u*)(Z + (size_t)row * ZP + g * 128 + 8 * ch); }
        *(LAS v4u*)(PB + (seg * 47 + rr) * 128 + 8 * ch) = val;
    }
    __syncthreads();
    { const int c = tid & 127, seg = tid >> 7, w = 2 << g;
        for (int tau = 0; tau < 32; ++tau) {
            float s = 0.f; const LAS unsigned short* p = PB + (seg * 47 + 15 + tau) * 128 + c;
            for (int j = 0; j < w; ++j) s += bf2f(p[-j * 128]);
            const int pos1 = r0 + 32 * seg + tau + 1; const int cnt = (sample || pos1 > w) ? w : pos1;
            const float pooled = s / (float)cnt - bf2f(p[0]);
            *(LAS unsigned short*)(LA + (c >> 6) * HTB + pg8::lds_byte(32 * seg + tau, c & 63)) = (unsigned short)f2bf(pooled);
        } }
    __syncthreads();
    const int wr = t.wave >> 2, wc = t.wave & 3, fr = t.lane & 15, fq = t.lane >> 4;
    f32x4 acc[4][2]; quad_mma(LA, LB, wr, wc, fr, fq, acc);
    const float* sc = a.in[10] + l * DPOOL + g * 128;
#pragma unroll
    for (int m = 0; m < 4; ++m)
#pragma unroll
        for (int n = 0; n < 2; ++n) { const int row = r0 + 64 * wr + 16 * m + fr, col = 32 * wc + 16 * n + 4 * fq; const f32x4 s4 = *(const f32x4*)(sc + col), o = acc[m][n] * s4;
            u32x2 w2; w2.x = pg8::cvt_pk_bf16(o[0], o[1]); w2.y = pg8::cvt_pk_bf16(o[2], o[3]); *(u32x2*)(CAT + (size_t)row * DM + g * 128 + col) = w2; }
}

__device__ __forceinline__ void sgu_unit(const Frame& F, const Args& a, int l, int T, int h) {
    LAS unsigned char* LA = F.lds + 0; LAS unsigned char* LB = F.lds + 32768; LAS float* RS = (LAS float*)(F.lds + 65536);
    const bf16* Z = (const bf16*)(a.ws + WS_Z); bf16* CAT = (bf16*)(a.ws + WS_CAT); const float* rowstat = (const float*)(a.ws + WS_ROWSTAT);
    const Tid t = get_tid(); const int r0 = 128 * T; const bool sample = r0 >= SEQ; const int tid = t.tid;
    __syncthreads();
    if (tid < 128) { const f32x4* rs = (const f32x4*)(rowstat + (size_t)(r0 + tid) * 12); const f32x4 s0 = rs[0], s1 = rs[1], s2 = rs[2];
        const float s = ((s0[0] + s0[1]) + (s0[2] + s0[3])) + ((s1[0] + s1[1]) + (s1[2] + s1[3])) + ((s2[0] + s2[1]) + (s2[2] + s2[3]));
        RS[tid] = 1.0f / sqrtf(s * (1.0f / DSGU) + EPS); }
    stage_image((const bf16*)(a.ws + (sample ? WS_SGAS : WS_SGA)) + (size_t)(l * 6 + h) * 16384, LA, tid);
    __syncthreads();
#pragma unroll
    for (int i = 0; i < 4; ++i) { const int it = tid + 512 * i, k = it >> 4, ch = it & 15;
        const v4u gv = *(const v4u*)(Z + (size_t)(r0 + k) * ZP + 1280 + 128 * h + 8 * ch);
        const float r = RS[k]; const float* gp = a.in[11] + l * DSGU + 128 * h + 8 * ch; const f32x4 g0 = *(const f32x4*)gp, g1 = *(const f32x4*)(gp + 4);
        float v[8]; v[0] = bflo(gv.x) * r * g0[0]; v[1] = bfhi(gv.x) * r * g0[1]; v[2] = bflo(gv.y) * r * g0[2]; v[3] = bfhi(gv.y) * r * g0[3];
        v[4] = bflo(gv.z) * r * g1[0]; v[5] = bfhi(gv.z) * r * g1[1]; v[6] = bflo(gv.w) * r * g1[2]; v[7] = bfhi(gv.w) * r * g1[3];
#pragma unroll
        for (int j = 0; j < 8; ++j) *(LAS unsigned short*)(LB + (k >> 6) * HTB + pg8::lds_byte(8 * ch + j, k & 63)) = (unsigned short)f2bf(v[j]);
        if (sample) { const int b = ((r0 - SEQ) >> 5) + (k >> 5), tau = k & 31; float* o = a.out + O_V + ((size_t)(l * DEC_B + b) * DEC_T + tau) * DSGU + 128 * h + 8 * ch;
            *(f32x4*)o = (f32x4){v[0], v[1], v[2], v[3]}; *(f32x4*)(o + 4) = (f32x4){v[4], v[5], v[6], v[7]}; }
    }
    __syncthreads();
    const int wr = t.wave >> 2, wc = t.wave & 3, fr = t.lane & 15, fq = t.lane >> 4;
    f32x4 acc[4][2]; quad_mma(LA, LB, wr, wc, fr, fq, acc);
    const float* sb = a.in[13] + (l * 6 + h) * 128;
#pragma unroll
    for (int m = 0; m < 4; ++m) { const int rl = 64 * wr + 16 * m + fr; const float bias = sb[sample ? (rl & 31) : rl];
#pragma unroll
        for (int n = 0; n < 2; ++n) { const int col = 512 + 128 * h + 32 * wc + 16 * n + 4 * fq; const u32x2 uu = *(const u32x2*)(Z + (size_t)(r0 + rl) * ZP + col);
            const f32x4 o = (f32x4){bflo(uu.x), bfhi(uu.x), bflo(uu.y), bfhi(uu.y)} * (acc[m][n] + bias);
            u32x2 w2; w2.x = pg8::cvt_pk_bf16(o[0], o[1]); w2.y = pg8::cvt_pk_bf16(o[2], o[3]); *(u32x2*)(CAT + (size_t)(r0 + rl) * DM + col) = w2; } }
}

__device__ __forceinline__ void conv_unit(const Frame& F, const Args& a, int l, int U) {
    LAS float* RED = (LAS float*)(F.lds + 0);
    const bf16* Z = (const bf16*)(a.ws + WS_Z); bf16* CAT = (bf16*)(a.ws + WS_CAT);
    const Tid t = get_tid(); const int r0 = 32 * U; const bool sample = r0 >= SEQ; const int tid = t.tid; const bool active = tid < 384; const int ch = active ? 2 * tid : 0;
    __syncthreads();
    unsigned win[62]; f32x2 wv[31];
#pragma unroll
    for (int i = 0; i < 62; ++i) {
        unsigned v = 0u;
        if (sample && i < 30) { const int b = (r0 - SEQ) >> 5; const f32x2 hv = *(const f32x2*)(a.in[3] + ((size_t)(l * DEC_B + b) * 30 + i) * DCONV + ch); v = pg8::cvt_pk_bf16(hv[0], hv[1]); }
        else { const int row = r0 - 30 + i; if (row >= 0) v = *(const unsigned*)(Z + (size_t)row * ZP + 2048 + ch); }
        win[i] = v;
    }
#pragma unroll
    for (int j = 0; j < 31; ++j) wv[j] = *(const f32x2*)(a.in[14] + ((size_t)l * CONVK + j) * DCONV + ch);
    const f32x2 cb = *(const f32x2*)(a.in[15] + l * DCONV + ch), lg = *(const f32x2*)(a.in[16] + l * DCONV + ch), lb = *(const f32x2*)(a.in[17] + l * DCONV + ch);
#pragma unroll
    for (int blk = 0; blk < 4; ++blk) {
        f32x2 y[8];
#pragma unroll
        for (int o = 0; o < 8; ++o) y[o] = cb;
#pragma unroll
        for (int i = 0; i < 38; ++i) { const unsigned u = win[8 * blk + i]; const f32x2 x = (f32x2){bflo(u), bfhi(u)};
#pragma unroll
            for (int o = 0; o < 8; ++o) { const int j = i - o; if (j >= 0 && j < 31) y[o] = y[o] + x * wv[j]; } }
        float st[16];
#pragma unroll
        for (int o = 0; o < 8; ++o) { const float s1 = active ? y[o][0] + y[o][1] : 0.f, s2 = active ? y[o][0] * y[o][0] + y[o][1] * y[o][1] : 0.f; st[2 * o] = wave_sum(s1); st[2 * o + 1] = wave_sum(s2); }
        if (t.lane == 0 && t.wave < 6) {
#pragma unroll
            for (int q = 0; q < 16; ++q) RED[((blk & 1) * 6 + t.wave) * 16 + q] = st[q]; }
        __syncthreads();
#pragma unroll
        for (int o = 0; o < 8; ++o) { float s1 = 0.f, s2 = 0.f;
#pragma unroll
            for (int w = 0; w < 6; ++w) { s1 += RED[((blk & 1) * 6 + w) * 16 + 2 * o]; s2 += RED[((blk & 1) * 6 + w) * 16 + 2 * o + 1]; }
            const float mean = s1 * (1.0f / DCONV), var = s2 * (1.0f / DCONV) - mean * mean, rstd = 1.0f / sqrtf(fmaxf(var, 0.f) + EPS);
            const float z0 = (y[o][0] - mean) * rstd * lg[0] + lb[0], z1 = (y[o][1] - mean) * rstd * lg[1] + lb[1];
            if (active) *(unsigned*)(CAT + (size_t)(r0 + 8 * blk + o) * DM + 1280 + ch) = pg8::cvt_pk_bf16(z0 * pg8::sigmoid_f(z0), z1 * pg8::sigmoid_f(z1)); }
    }
}
__device__ __forceinline__ void state_copy(const Frame& F, const Args& a, int l) {
    const bf16* Z = (const bf16*)(a.ws + WS_Z); const Tid t = get_tid();
    const int gt = F.vcu * (NWAVES * 64) + t.tid, NGT = F.G * NWAVES * 64;
    for (int e = gt; e < 522240; e += NGT) {
        size_t zi, oi;
        if (e < 7680) { const int r = e >> 9, c = e & 511; zi = (size_t)(SEQ - 15 + r) * ZP + c; oi = O_POOLP + (size_t)l * 7680 + e; }
        else if (e < 30720) { const int e2 = e - 7680, r = e2 / 768, c = e2 % 768; zi = (size_t)(SEQ - 30 + r) * ZP + 2048 + c; oi = O_CONVP + (size_t)l * 23040 + e2; }
        else if (e < 153600) { const int e2 = e - 30720, b = e2 / 7680, rem = e2 % 7680, r = rem >> 9, c = rem & 511; zi = (size_t)(SEQ + b * 32 + 17 + r) * ZP + c; oi = O_POOLS + (size_t)(l * DEC_B + b) * 7680 + rem; }
        else { const int e2 = e - 153600, b = e2 / 23040, rem = e2 % 23040, r = rem / 768, c = rem % 768; zi = (size_t)(SEQ + b * 32 + 2 + r) * ZP + 2048 + c; oi = O_CONVS + (size_t)(l * DEC_B + b) * 23040 + rem; }
        a.out[oi] = bf2f(Z[zi]);
    }
}
__device__ __forceinline__ void mixer_phase(const Frame& F, const Args& a, int l) {
    constexpr int NT = M / 128, NSGU = NT * 6, NCONV = M / 32, NPOOL = NT * 4;
    for (int u = F.vcu; u < NSGU; u += F.G) sgu_unit(F, a, l, u / 6, u % 6);
    for (int u = (F.vcu + F.G - (NSGU % 256)) % F.G; u < NCONV; u += F.G) conv_unit(F, a, l, u);
    for (int u = (F.vcu + F.G - ((NSGU + NCONV) % 256)) % F.G; u < NPOOL; u += F.G) pool_unit(F, a, l, u >> 2, u & 3);
    state_copy(F, a, l);
}

__global__ void __launch_bounds__(NWAVES * 64, 2) fwd_kernel(Args args) {
    extern __shared__ __attribute__((aligned(16))) unsigned char lds[];
    Frame F;
    F.lds = (LAS unsigned char*)lds; F.MISC = (volatile LAS unsigned*)(F.lds + MISC_OFF);
    F.G = gridDim.x; { const int bx = blockIdx.x; F.vcu = (F.G % 8 == 0) ? (bx % 8) * (F.G / 8) + bx / 8 : bx; }
    F.ctl = (gu32*)(args.ws + WS_CTL);
    for (int u = threadIdx.x; u < (LDS_BYTES - LDSCTL_OFF) / 4; u += NWAVES * 64) ((LAS unsigned*)(F.lds + LDSCTL_OFF))[u] = 0u;
    __syncthreads();
    XcdBarrier bar; bar.bar = (unsigned*)(F.ctl + CW_BAR); bar.x = 0; bar.st = nullptr;
    if (!MK_MULTI) bar = xcd_barrier_post((unsigned*)(F.ctl + CW_BAR), F.MISC + 8);
    const int lo = args.ph_lo, hi = args.ph_hi;
#define IN(k) (lo <= (k) && (k) < hi)
#define SEAM(k) do { if (IN(k) && IN((k) + 1)) xcd_barrier(bar); } while (0)
    const float* ng = args.in[4];
    bf16* Wb = (bf16*)(args.ws + WS_W); bf16* H = (bf16*)(args.ws + WS_H); bf16* CAT = (bf16*)(args.ws + WS_CAT); bf16* HID = (bf16*)(args.ws + WS_HID); bf16* Z = (bf16*)(args.ws + WS_Z);
    float* Y = (float*)(args.ws + WS_Y); float* rowstat = (float*)(args.ws + WS_ROWSTAT);

    if (IN(0)) { convert_weights(F, args); convert_small(F, args); norm_phase<0>(F, args, nullptr, 0.f, ng); }
    SEAM(0);
    for (int l0 = 0; l0 < DEPTH; ++l0) {
        for (int s0 = 0; s0 < 3; ++s0) {
            int l = l0, s = s0; asm volatile("" : "+s"(l), "+s"(s));
            const bf16* wl = Wb + (size_t)l * WL_TOTAL; const int pb = 1 + 10 * l;
            if (s != 1) {
                const int p0 = pb + (s ? 7 : 0);
                if (IN(p0)) { pg8::Gemm g{H, wl + (s ? WL_GU2 : WL_GU1), M, NGU, DM}; pg8::StaticOrder S; S.init(M, NGU, F.G, (int)blockIdx.x); pg8::EpiSwiGLU E{HID, DFF};
                    pg8::gemm_phase<pg8::EpiSwiGLU, pg8::StaticOrder, true, true>(F.lds + RING_OFF, g, S, E); }
                SEAM(p0);
                if (IN(p0 + 1)) { pg8::Gemm g{HID, wl + (s ? WL_D2 : WL_D1), M, DM, DFF}; pg8::StaticOrder S; S.init(M, DM, F.G, (int)blockIdx.x); pg8::EpiF32Y E{Y, DM};
                    pg8::gemm_phase<pg8::EpiF32Y, pg8::StaticOrder, true, true>(F.lds + RING_OFF, g, S, E); }
                SEAM(p0 + 1);
                if (IN(p0 + 2)) { const float* gpost = ng + (size_t)(l * 6 + (s ? 5 : 1)) * DM;
                    if (s == 0) norm_phase<1>(F, args, gpost, 0.5f, ng + (size_t)(l * 6 + 2) * DM);
                    else if (l + 1 < DEPTH) norm_phase<1>(F, args, gpost, 0.5f, ng + (size_t)((l + 1) * 6 + 0) * DM);
                    else norm_phase<2>(F, args, gpost, 0.5f, nullptr); }
                SEAM(p0 + 2);
            } else {
                const int p0 = pb + 3;
                if (IN(p0)) { pg8::Gemm g{H, wl + WL_IN, M, DIN, DM}; pg8::StaticOrder S; S.init(M, DIN, F.G, (int)blockIdx.x); pg8::EpiWin E{Z, ZP, rowstat};
                    pg8::gemm_phase<pg8::EpiWin, pg8::StaticOrder, true, true>(F.lds + RING_OFF, g, S, E); }
                SEAM(p0);
                if (IN(p0 + 1)) mixer_phase(F, args, l);
                SEAM(p0 + 1);
                if (IN(p0 + 2)) { pg8::Gemm g{CAT, wl + WL_OUT, M, DM, DM}; pg8::StaticOrder S; S.init(M, DM, F.G, (int)blockIdx.x); pg8::EpiF32Y E{Y, DM};
                    pg8::gemm_phase<pg8::EpiF32Y, pg8::StaticOrder, true, true>(F.lds + RING_OFF, g, S, E); }
                SEAM(p0 + 2);
                if (IN(p0 + 3)) norm_phase<1>(F, args, ng + (size_t)(l * 6 + 3) * DM, 1.0f, ng + (size_t)(l * 6 + 4) * DM);
                SEAM(p0 + 3);
            }
        }
    }
#undef IN
#undef SEAM
}

extern "C" void kernel_launch(void* const* d_in, const int* in_sizes, int n_in, void* d_out, int out_size, void* d_ws, size_t ws_size, hipStream_t stream) {
    static int grid = 0;
    if (grid == 0) {
        if (n_in != 19 || (size_t)out_size != O_END || ws_size < WS_END) { fprintf(stderr, "kernel_launch: unexpected sizes: n_in %d out %d ws %zu (need %zu)\n", n_in, out_size, ws_size, (size_t)WS_END); grid = -1; return; }
        int dev = 0, cus = 0, per_cu = 0;
        if (hipGetDevice(&dev) != hipSuccess || hipDeviceGetAttribute(&cus, hipDeviceAttributeMultiprocessorCount, dev) != hipSuccess) { grid = -1; return; }
        if (hipFuncSetAttribute((const void*)fwd_kernel, hipFuncAttributeMaxDynamicSharedMemorySize, LDS_BYTES) != hipSuccess) { fprintf(stderr, "kernel_launch: hipFuncSetAttribute failed\n"); grid = -1; return; }
        if (hipOccupancyMaxActiveBlocksPerMultiprocessor(&per_cu, (const void*)fwd_kernel, NWAVES * 64, LDS_BYTES) != hipSuccess || per_cu < 1) fprintf(stderr, "kernel_launch: occupancy query says %d\n", per_cu);
        (void)hipGetLastError();
        grid = cus;
    }
    if (grid < 0) return;
    (void)hipMemsetAsync((char*)d_ws + WS_CTL, 0, CTL_ZERO_BYTES, stream);
    Args a{};
    for (int i = 0; i < 19; ++i) a.in[i] = (const float*)d_in[i];
    a.out = (float*)d_out; a.ws = (unsigned char*)d_ws;
#if MK_MULTI
    for (int p = 0; p < NPHASE; ++p) { a.ph_lo = p; a.ph_hi = p + 1; hipLaunchKernelGGL(fwd_kernel, dim3(grid), dim3(NWAVES * 64), LDS_BYTES, stream, a); }
#else
    a.ph_lo = 0; a.ph_hi = NPHASE; hipLaunchKernelGGL(fwd_kernel, dim3(grid), dim3(NWAVES * 64), LDS_BYTES, stream, a);
#endif
}
```

```cpp
#include <hip/hip_runtime.h>
#include <cstdio>
#include <cstdint>
#define MK_MULTI 0
namespace pg8 {
#define PG8_LAS __attribute__((address_space(3)))
typedef unsigned short bf16_t;
typedef short bf16x8 __attribute__((ext_vector_type(8)));
typedef float f32x4 __attribute__((ext_vector_type(4)));
typedef unsigned u32x4 __attribute__((ext_vector_type(4)));
constexpr int BM = 256, BK = 64, HALF = 128, HTB = HALF * BK * 2  , STAGE_BYTES = 8 * HTB, NXCD = 8, WGM = 8;

__host__ __device__ __forceinline__ int lds_byte(int r, int c) { const int st = (r >> 4) * 2 + (c >> 5), rr = r & 15, cc = c & 31, ob = rr * 64 + cc * 2; return st * 1024 + (ob ^ (((ob >> 9) & 1) << 5)); }
__host__ __device__ __forceinline__ void stage_rc(int b, int& R, int& C) { const int st = b / 1024, sb = b % 1024, swz = sb ^ (((sb >> 9) & 1) << 5); R = (st >> 1) * 16 + swz / 64; C = (st & 1) * 32 + (swz % 64) / 2; }
__host__ __device__ __forceinline__ int perm32(int rho) { const int n = rho >> 4, i = rho & 15; return 8 * (i >> 2) + 4 * n + (i & 3); }

__device__ __forceinline__ int opaque_tid() { int t = threadIdx.x; asm volatile("" : "+v"(t)); return t; }
struct Unit { int pm, pn; };
struct Gemm { const bf16_t* A; const bf16_t* Bt; int M, N, K; };

struct StaticOrder {
    int nM, nN, nwg, G, c;
    __host__ __device__ void init(int M, int N, int G_, int c_) { nM = M / BM; nN = N / BM; nwg = nM * nN; G = G_; c = c_; }
    __host__ __device__ bool next(int i, Unit& u) const {
        const long L = (long)i * G + c; if (L >= nwg) return false;
        int wgid = (int)L; { const int q = nwg / NXCD, r = nwg % NXCD, xcd = wgid % NXCD, off = wgid / NXCD; wgid = (xcd < r ? xcd * (q + 1) : r * (q + 1) + (xcd - r) * q) + off; }
        const int nig = WGM * nN, gid = wgid / nig, fm = gid * WGM, gsz = (nM - fm) < WGM ? (nM - fm) : WGM;
        u.pm = fm + ((wgid % nig) % gsz); u.pn = (wgid % nig) / gsz; return true;
    }
    __device__ __forceinline__ void a_ready(const Unit&) const {}
    __device__ __forceinline__ void done(const Unit&) const {}
};
__device__ __forceinline__ unsigned cvt_pk_bf16(float lo, float hi) { unsigned r; asm volatile("v_cvt_pk_bf16_f32 %0, %1, %2" : "=v"(r) : "v"(lo), "v"(hi)); return r; }
typedef float f32x2 __attribute__((ext_vector_type(2)));
__device__ __forceinline__ f32x2 gelu_pk(f32x2 v) {
    const f32x2 av = __builtin_elementwise_abs(v), d = av * 0.2316418882f + 1.0f;
    f32x2 t; t.x = __builtin_amdgcn_rcpf(d.x); t.y = __builtin_amdgcn_rcpf(d.y);
    f32x2 q = t * 0.5307027145f + (-0.7265760135f); q = q * t + 0.7107068705f; q = q * t + (-0.142248368f); q = q * t + 0.127414796f; q = q * t;
    const f32x2 s = (v * v) * (-0.72134752044f);
    f32x2 e; e.x = __builtin_amdgcn_exp2f(s.x); e.y = __builtin_amdgcn_exp2f(s.y);
    const f32x2 m = v * (q * e), r = v - m;
    f32x2 o; o.x = v.x < 0.f ? m.x : r.x; o.y = v.y < 0.f ? m.y : r.y; return o;
}
__device__ __forceinline__ float sigmoid_f(float x) { return __builtin_amdgcn_rcpf(1.0f + __builtin_amdgcn_exp2f(x * -1.44269504089f)); }
struct EpiF32Y {
    static constexpr bool PERM = false, AFTER_DRAIN = false;
    float* C; int ldc;
    __device__ __forceinline__ void operator()(const f32x4 (&acc)[2][2][4][2], const Unit& u, int wr, int wc, int fr, int fq) const {
        const int row0 = u.pm * BM + wr * 64 + fr, col0 = u.pn * BM + wc * 32 + 4 * fq;
#pragma unroll
        for (int ai = 0; ai < 2; ++ai)
#pragma unroll
            for (int m = 0; m < 4; ++m) { float* rowp = C + (size_t)(row0 + ai * HALF + m * 16) * ldc + col0;
#pragma unroll
                for (int bj = 0; bj < 2; ++bj)
#pragma unroll
                    for (int n = 0; n < 2; ++n) *(f32x4*)(rowp + bj * HALF + n * 16) = acc[ai][bj][m][n]; }
    }
};
struct EpiSwiGLU {
    static constexpr bool PERM = true, AFTER_DRAIN = false;
    bf16_t* O; int ldc;
    __device__ __forceinline__ void operator()(const f32x4 (&acc)[2][2][4][2], const Unit& u, int wr, int wc, int fr, int fq) const {
        const int row0 = u.pm * BM + wr * 64 + fr, col0 = u.pn * HALF + wc * 32 + 8 * fq;
#pragma unroll
        for (int ai = 0; ai < 2; ++ai)
#pragma unroll
            for (int m = 0; m < 4; ++m) { bf16_t* rowp = O + (size_t)(row0 + ai * HALF + m * 16) * ldc + col0;
                float h[8];
#pragma unroll
                for (int n = 0; n < 2; ++n)
#pragma unroll
                    for (int j = 0; j < 4; ++j) { const float g = acc[ai][0][m][n][j], up = acc[ai][1][m][n][j]; h[4 * n + j] = g * sigmoid_f(g) * up; }
                u32x4 w; w.x = cvt_pk_bf16(h[0], h[1]); w.y = cvt_pk_bf16(h[2], h[3]); w.z = cvt_pk_bf16(h[4], h[5]); w.w = cvt_pk_bf16(h[6], h[7]);
                *(u32x4*)rowp = w; }
    }
};
struct EpiWin {
    static constexpr bool PERM = true, AFTER_DRAIN = false;
    bf16_t* Z; int ldc; float* rowstat;
    __device__ __forceinline__ void operator()(const f32x4 (&acc)[2][2][4][2], const Unit& u, int wr, int wc, int fr, int fq) const {
        const int row0 = u.pm * BM + wr * 64 + fr; const int pn = u.pn;
        if (pn < 8) {
            const int col0 = pn * BM + wc * 32 + 8 * fq; const bool act = pn >= 2, stat = pn >= 5;
#pragma unroll
            for (int ai = 0; ai < 2; ++ai)
#pragma unroll
                for (int m = 0; m < 4; ++m) { const int row = row0 + ai * HALF + m * 16; bf16_t* rowp = Z + (size_t)row * ldc + col0; float ss = 0.f;
#pragma unroll
                    for (int bj = 0; bj < 2; ++bj) { f32x4 v0 = acc[ai][bj][m][0], v1 = acc[ai][bj][m][1];
                        if (act) { f32x2 a = gelu_pk((f32x2){v0[0], v0[1]}), b = gelu_pk((f32x2){v0[2], v0[3]}), c = gelu_pk((f32x2){v1[0], v1[1]}), d = gelu_pk((f32x2){v1[2], v1[3]});
                            v0 = (f32x4){a.x, a.y, b.x, b.y}; v1 = (f32x4){c.x, c.y, d.x, d.y}; }
                        ss += (v0[0] * v0[0] + v0[1] * v0[1]) + (v0[2] * v0[2] + v0[3] * v0[3]) + (v1[0] * v1[0] + v1[1] * v1[1]) + (v1[2] * v1[2] + v1[3] * v1[3]);
                        u32x4 w; w.x = cvt_pk_bf16(v0[0], v0[1]); w.y = cvt_pk_bf16(v0[2], v0[3]); w.z = cvt_pk_bf16(v1[0], v1[1]); w.w = cvt_pk_bf16(v1[2], v1[3]);
                        *(u32x4*)(rowp + bj * HALF) = w; }
                    if (stat) { ss += __shfl_xor(ss, 16); ss += __shfl_xor(ss, 32); if (fq == 0) rowstat[(size_t)row * 12 + (pn - 5) * 4 + wc] = ss; } }
        } else {
            const int col0 = 2048 + (pn - 8) * HALF + wc * 32 + 8 * fq;
#pragma unroll
            for (int ai = 0; ai < 2; ++ai)
#pragma unroll
                for (int m = 0; m < 4; ++m) { bf16_t* rowp = Z + (size_t)(row0 + ai * HALF + m * 16) * ldc + col0;
                    float h[8];
#pragma unroll
                    for (int n = 0; n < 2; ++n)
#pragma unroll
                        for (int j = 0; j < 4; ++j) h[4 * n + j] = acc[ai][0][m][n][j] * sigmoid_f(acc[ai][1][m][n][j]);
                    u32x4 w; w.x = cvt_pk_bf16(h[0], h[1]); w.y = cvt_pk_bf16(h[2], h[3]); w.z = cvt_pk_bf16(h[4], h[5]); w.w = cvt_pk_bf16(h[6], h[7]);
                    *(u32x4*)rowp = w; }
        }
    }
};
template <class Epi, class Sched, bool ALIGN_EPI = false, bool SP2 = false>
__device__ __forceinline__ void gemm_phase(PG8_LAS unsigned char* lds, const Gemm g, const Sched& S, const Epi& E) {
    const int tid = opaque_tid(), wid = __builtin_amdgcn_readfirstlane(tid >> 6), lane = tid & 63, wr = wid >> 2, wc = wid & 3, fr = lane & 15, fq = lane >> 4;
    const int K = g.K, nt = K / BK;
    unsigned voffA[2], voffB[2];
#pragma unroll
    for (int i = 0; i < 2; ++i) { int R, C; stage_rc(tid * 16 + i * 8192, R, C); const int Rb = Epi::PERM ? ((R & ~31) + perm32(R & 31)) : R;
        voffA[i] = (unsigned)(R * K + C) * 2u; voffB[i] = (unsigned)(Rb * K + C) * 2u; }
    const size_t kstep = (size_t)(BK * 2);
    const size_t hstep = (size_t)HALF * K * 2;
    const size_t tstep = 2 * hstep;
    const unsigned ldsw = (unsigned)wid * 1024u;
    const int aoff = lds_byte(wr * 64 + fr, fq * 8), boff = lds_byte(wc * 32 + fr, fq * 8);
#define PG8_SA(b, h) (((b) * 2 + (h)) * HTB)
#define PG8_SB(b, h) ((4 + (b) * 2 + (h)) * HTB)
#define PG8_STAGE(bufoff, gbase, voff) do { _Pragma("unroll") for (int _i = 0; _i < 2; ++_i) \
        __builtin_amdgcn_global_load_lds((const unsigned*)((const char*)(gbase) + (voff)[_i]), (PG8_LAS unsigned*)(lds + (bufoff) + ldsw + _i * 8192), 16, 0, 0); } while (0)
#define PG8_LDA(dst, b, h) do { _Pragma("unroll") for (int m = 0; m < 4; ++m) _Pragma("unroll") for (int k = 0; k < 2; ++k) dst[m][k] = *(const PG8_LAS bf16x8*)(lds + PG8_SA(b, h) + aoff + m * 2048 + k * 1024); } while (0)
#define PG8_LDB(dst, b, h) do { _Pragma("unroll") for (int n = 0; n < 2; ++n) _Pragma("unroll") for (int k = 0; k < 2; ++k) dst[n][k] = *(const PG8_LAS bf16x8*)(lds + PG8_SB(b, h) + boff + n * 2048 + k * 1024); } while (0)
#define PG8_MMA(ai, bj, At, Bt) do { __builtin_amdgcn_s_setprio(1); _Pragma("unroll") for (int m = 0; m < 4; ++m) _Pragma("unroll") for (int n = 0; n < 2; ++n) _Pragma("unroll") for (int k = 0; k < 2; ++k) \
        acc[ai][bj][m][n] = __builtin_amdgcn_mfma_f32_16x16x32_bf16(Bt[n][k], At[m][k], acc[ai][bj][m][n], 0, 0, 0); __builtin_amdgcn_s_setprio(0); } while (0)
#define PG8_WAIT_V(n) asm volatile("s_waitcnt vmcnt(" #n ")" ::: "memory")
#define PG8_WAIT_L(n) asm volatile("s_waitcnt lgkmcnt(" #n ")" ::: "memory")
#define PG8_BAR __builtin_amdgcn_s_barrier()
#define PG8_SCHED __builtin_amdgcn_sched_barrier(0)
    Unit cur, nxt; int ui = 0;
    if (!S.next(0, cur)) return;
    f32x4 acc[2][2][4][2];
#pragma unroll
    for (int a = 0; a < 2; ++a)
#pragma unroll
        for (int b = 0; b < 2; ++b)
#pragma unroll
            for (int m = 0; m < 4; ++m)
#pragma unroll
                for (int n = 0; n < 2; ++n) acc[a][b][m][n] = (f32x4){0.f, 0.f, 0.f, 0.f};
    bf16x8 At[4][2], B0[2][2], B1[2][2];
    const char* cA = (const char*)g.A + (size_t)cur.pm * tstep; const char* cB = (const char*)g.Bt + (size_t)cur.pn * tstep;
    S.a_ready(cur);
    if constexpr (SP2) {
        PG8_STAGE(PG8_SB(0, 0), cB, voffB); PG8_STAGE(PG8_SB(0, 1), cB + hstep, voffB); PG8_STAGE(PG8_SA(0, 0), cA, voffA); PG8_STAGE(PG8_SA(0, 1), cA + hstep, voffA);
        if (wr == 1) PG8_BAR;
        PG8_WAIT_V(2); PG8_BAR;
        PG8_STAGE(PG8_SB(1, 0), cB + kstep, voffB); PG8_STAGE(PG8_SA(1, 0), cA + kstep, voffA); PG8_STAGE(PG8_SB(1, 1), cB + hstep + kstep, voffB);
        PG8_WAIT_V(6); PG8_BAR;
    } else {
        PG8_STAGE(PG8_SB(0, 0), cB, voffB); PG8_STAGE(PG8_SA(0, 0), cA, voffA); PG8_STAGE(PG8_SB(0, 1), cB + hstep, voffB); PG8_STAGE(PG8_SA(0, 1), cA + hstep, voffA);
        if (wr == 1) PG8_BAR;
        PG8_WAIT_V(4); PG8_BAR;
        PG8_STAGE(PG8_SB(1, 0), cB + kstep, voffB); PG8_STAGE(PG8_SA(1, 0), cA + kstep, voffA); PG8_STAGE(PG8_SB(1, 1), cB + hstep + kstep, voffB);
        PG8_WAIT_V(6); PG8_BAR;
    }
    for (;;) {
        const bool has_next = S.next(ui + 1, nxt);
        const char* nA = has_next ? (const char*)g.A + (size_t)nxt.pm * tstep : cA; const char* nB = has_next ? (const char*)g.Bt + (size_t)nxt.pn * tstep : cB;
        for (int t = 0; t < nt; t += 2) {
            const bool last = (t == nt - 2);
            const char* a1 = cA + (size_t)(t + 1) * kstep;
            const char* a2 = last ? nA : cA + (size_t)(t + 2) * kstep; const char* b2 = last ? nB : cB + (size_t)(t + 2) * kstep;
            const char* a3 = a2 + kstep; const char* b3 = b2 + kstep;
            if (last && has_next) S.a_ready(nxt);
            if constexpr (SP2) {
            PG8_LDB(B0, 0, 0); PG8_LDB(B1, 0, 1); PG8_SCHED; PG8_LDA(At, 0, 0); PG8_STAGE(PG8_SA(1, 1), a1 + hstep, voffA);
            PG8_WAIT_V(8); PG8_WAIT_L(0); PG8_BAR; PG8_MMA(0, 0, At, B0); PG8_MMA(0, 1, At, B1); PG8_BAR; PG8_SCHED;
            PG8_LDA(At, 0, 1); PG8_STAGE(PG8_SB(0, 0), b2, voffB); PG8_STAGE(PG8_SB(0, 1), b2 + hstep, voffB); PG8_STAGE(PG8_SA(0, 0), a2, voffA);
            PG8_WAIT_V(8); PG8_WAIT_L(0); PG8_BAR; PG8_MMA(1, 0, At, B0); PG8_MMA(1, 1, At, B1); PG8_BAR; PG8_SCHED;
            PG8_LDB(B0, 1, 0); PG8_LDB(B1, 1, 1); PG8_SCHED; PG8_LDA(At, 1, 0); PG8_STAGE(PG8_SA(0, 1), a2 + hstep, voffA);
            PG8_WAIT_V(8); PG8_WAIT_L(0); PG8_BAR; PG8_MMA(0, 0, At, B0); PG8_MMA(0, 1, At, B1); PG8_BAR; PG8_SCHED;
            PG8_LDA(At, 1, 1); PG8_STAGE(PG8_SB(1, 0), b3, voffB); PG8_STAGE(PG8_SB(1, 1), b3 + hstep, voffB); PG8_STAGE(PG8_SA(1, 0), a3, voffA);
            PG8_WAIT_V(8); PG8_WAIT_L(0); PG8_BAR; PG8_MMA(1, 0, At, B0); PG8_MMA(1, 1, At, B1); PG8_BAR; PG8_SCHED;
            } else {
            PG8_LDB(B0, 0, 0); PG8_SCHED; PG8_LDA(At, 0, 0); PG8_STAGE(PG8_SA(1, 1), a1 + hstep, voffA);
            PG8_WAIT_L(8); PG8_BAR; PG8_WAIT_L(0); PG8_MMA(0, 0, At, B0); PG8_BAR; PG8_SCHED;
            PG8_LDB(B1, 0, 1); PG8_STAGE(PG8_SB(0, 0), b2, voffB);
            PG8_BAR; PG8_WAIT_L(0); PG8_MMA(0, 1, At, B1); PG8_BAR;
            PG8_LDA(At, 0, 1); PG8_STAGE(PG8_SA(0, 0), a2, voffA);
            PG8_BAR; PG8_WAIT_L(0); PG8_MMA(1, 0, At, B0); PG8_BAR; PG8_SCHED;
            PG8_STAGE(PG8_SB(0, 1), b2 + hstep, voffB);
            PG8_WAIT_V(6); PG8_BAR; PG8_MMA(1, 1, At, B1); PG8_BAR;
            PG8_LDB(B0, 1, 0); PG8_SCHED; PG8_LDA(At, 1, 0); PG8_STAGE(PG8_SA(0, 1), a2 + hstep, voffA);
            PG8_WAIT_L(8); PG8_BAR; PG8_WAIT_L(0); PG8_MMA(0, 0, At, B0); PG8_BAR; PG8_SCHED;
            PG8_LDB(B1, 1, 1); PG8_STAGE(PG8_SB(1, 0), b3, voffB);
            PG8_BAR; PG8_WAIT_L(0); PG8_MMA(0, 1, At, B1); PG8_BAR;
            PG8_LDA(At, 1, 1); PG8_STAGE(PG8_SA(1, 0), a3, voffA);
            PG8_BAR; PG8_WAIT_L(0); PG8_MMA(1, 0, At, B0); PG8_BAR; PG8_SCHED;
            PG8_STAGE(PG8_SB(1, 1), b3 + hstep, voffB);
            PG8_WAIT_V(6); PG8_BAR; PG8_MMA(1, 1, At, B1); PG8_BAR;
            }
        }
        if constexpr (ALIGN_EPI) { if (wr == 0) PG8_BAR; }
        if constexpr (!Epi::AFTER_DRAIN) { E(acc, cur, wr, wc, fr, fq); S.done(cur); }
        if (!has_next) break;
#pragma unroll
        for (int a = 0; a < 2; ++a)
#pragma unroll
            for (int b = 0; b < 2; ++b)
#pragma unroll
                for (int m = 0; m < 4; ++m)
#pragma unroll
                    for (int n = 0; n < 2; ++n) acc[a][b][m][n] = (f32x4){0.f, 0.f, 0.f, 0.f};
        cur = nxt; cA = nA; cB = nB; ++ui;
        if constexpr (ALIGN_EPI) { if (wr == 1) PG8_BAR; }
    }
    PG8_WAIT_V(0);
    if constexpr (!ALIGN_EPI) { if (wr == 0) PG8_BAR; }
    PG8_BAR;
    if constexpr (Epi::AFTER_DRAIN) { E.fused(acc, cur, wr, wc, fr, fq, lds, wid, lane); S.done(cur); }
#undef PG8_SA
#undef PG8_SB
#undef PG8_STAGE
#undef PG8_LDA
#undef PG8_LDB
#undef PG8_MMA
#undef PG8_WAIT_V
#undef PG8_WAIT_L
#undef PG8_BAR
#undef PG8_SCHED
}
}
#define GAS __attribute__((address_space(1)))
#define LAS __attribute__((address_space(3)))
typedef unsigned short bf16;
typedef unsigned v4u __attribute__((ext_vector_type(4)));
typedef float f32x4 __attribute__((ext_vector_type(4)));
typedef short bf16x8 __attribute__((ext_vector_type(8)));
typedef GAS unsigned gu32;
typedef GAS unsigned long long gu64;
#define RLX_AGENT __ATOMIC_RELAXED, __HIP_MEMORY_SCOPE_AGENT
#define LDS_WAIT() asm volatile("s_waitcnt lgkmcnt(0)" ::: "memory")
#define VM_WAIT() asm volatile("s_waitcnt vmcnt(0)" ::: "memory")
__device__ __forceinline__ unsigned long long rt() { return __builtin_amdgcn_s_memrealtime(); }
__device__ __forceinline__ unsigned f2bf(float f) { unsigned u = __builtin_bit_cast(unsigned, f); return (u + 0x7fffu + ((u >> 16) & 1u)) >> 16; }
__device__ __forceinline__ unsigned pk2(float lo, float hi) { return f2bf(lo) | (f2bf(hi) << 16); }

#define XB_TMO      128
#define XB_XCNT(j)  (256  + 64 * (j))
#define XB_XSUB(j)  (1280 + 64 * (j))
#define XB_XGEN(j)  (2304 + 64 * (j))
#define XB_TOP      3328
#define XB_TOPGEN   3392
#define XCD_BAR_WORDS 3456
#define XB_SPIN_CAP (1u << 18)

__device__ __forceinline__ unsigned xb_ld(unsigned* p)              { return __hip_atomic_load(p, __ATOMIC_RELAXED, __HIP_MEMORY_SCOPE_AGENT); }
__device__ __forceinline__ unsigned xb_add(unsigned* p, unsigned v) { return __hip_atomic_fetch_add(p, v, __ATOMIC_RELAXED, __HIP_MEMORY_SCOPE_AGENT); }
__device__ __forceinline__ unsigned xb_xcc_id() { return (unsigned)__builtin_amdgcn_s_getreg((3 << 11) | 20) & 0xFu; }
#define XB_SPIN(cond, bar) do { unsigned _sp = 0; while (cond) { __builtin_amdgcn_s_sleep(1); \
    if ((++_sp & 255u) == 0u) { if (xb_ld(&(bar)[XB_TMO])) break; if (_sp > XB_SPIN_CAP) { atomicAdd(&(bar)[XB_TMO], 1u); break; } } } } while (0)

struct XcdBarrier {
    unsigned* bar; unsigned x;
    volatile LAS unsigned* st;
};

__device__ __forceinline__ XcdBarrier xcd_barrier_post(unsigned* bar, volatile LAS unsigned* st) {
    XcdBarrier b; b.bar = bar; b.x = xb_xcc_id(); b.st = st;
    if (threadIdx.x == 0) (void)xb_add(&bar[XB_XCNT(b.x)], 1u);
    return b;
}
__device__ __forceinline__ void xcd_barrier_complete(unsigned* bar, unsigned x, unsigned& nloc, unsigned& nx) {
    const unsigned G = gridDim.x * gridDim.y * gridDim.z;
    unsigned sum, cnt, mine, sp = 0u;
    for (;;) {
        sum = 0u; cnt = 0u; mine = 0u;
#pragma unroll
        for (unsigned j = 0; j < 16; ++j) { const unsigned c = xb_ld(&bar[XB_XCNT(j)]); sum += c; cnt += (c > 0u) ? 1u : 0u; mine = (j == x) ? c : mine; }
        if (sum == G) break;
        __builtin_amdgcn_s_sleep(1);
        if ((++sp & 255u) == 0u) { if (xb_ld(&bar[XB_TMO])) break; if (sp > XB_SPIN_CAP) { atomicAdd(&bar[XB_TMO], 1u); break; } }
    }
    nloc = mine > 0u ? mine : 1u; nx = cnt > 0u ? cnt : 1u;
}

__device__ __forceinline__ void xcd_barrier(const XcdBarrier& b) {
    asm volatile("s_waitcnt vmcnt(0)" ::: "memory");
    __syncthreads();
    if (threadIdx.x == 0) {
        unsigned* bar = b.bar;
        __builtin_amdgcn_s_waitcnt(0);
        unsigned nloc = b.st[0], nx = b.st[1];
        if (nloc == 0u) { xcd_barrier_complete(bar, b.x, nloc, nx); b.st[0] = nloc; b.st[1] = nx; }
        const unsigned old = xb_add(&bar[XB_XSUB(b.x)], 1u);
        const unsigned gen = old / nloc;
        if (old + 1u == (gen + 1u) * nloc) {
            __builtin_amdgcn_fence(__ATOMIC_RELEASE, "agent");
            asm volatile("s_waitcnt vmcnt(0)" ::: "memory");
            const unsigned og = xb_add(&bar[XB_TOP], 1u);
            const unsigned tg = og / nx;
            if (og + 1u == (tg + 1u) * nx) xb_add(&bar[XB_TOPGEN], 1u);
            else XB_SPIN(xb_ld(&bar[XB_TOPGEN]) == tg, bar);
            __builtin_amdgcn_fence(__ATOMIC_ACQUIRE, "agent");
            xb_add(&bar[XB_XGEN(b.x)], 1u);
            asm volatile("s_waitcnt vmcnt(0)" ::: "memory");
        } else {
            XB_SPIN(xb_ld(&bar[XB_XGEN(b.x)]) == gen, bar);
            __builtin_amdgcn_fence(__ATOMIC_ACQUIRE, "agent");
            asm volatile("s_waitcnt vmcnt(0)" ::: "memory");
        }
    }
    __syncthreads();
}
constexpr int NWAVES = 8;
constexpr int DM = 2048, SEQ = 16384, DEPTH = 4, DEC_B = 16, DEC_T = 32, MS = DEC_B * DEC_T, M = SEQ + MS;
constexpr int DFF = 5632, DIN = 3584, DPOOL = 512, DSGU = 768, DCONV = 768, CONVK = 31, ZP = 2816;
constexpr int NGU = 2 * DFF;
constexpr float EPS = 1e-6f;
#ifndef MK_MULTI
#define MK_MULTI 0
#endif
constexpr int NPHASE = 1 + 10 * DEPTH;
constexpr size_t O_Y = 0, O_POOLP = (size_t)M * DM, O_CONVP = O_POOLP + (size_t)DEPTH * 15 * DPOOL, O_POOLS = O_CONVP + (size_t)DEPTH * 30 * DCONV,
                 O_CONVS = O_POOLS + (size_t)DEPTH * DEC_B * 15 * DPOOL, O_V = O_CONVS + (size_t)DEPTH * DEC_B * 30 * DCONV, O_END = O_V + (size_t)DEPTH * DEC_B * DEC_T * DSGU;
constexpr size_t MiB = 1u << 20;
constexpr size_t WS_CTL = 0, CTL_ZERO_BYTES = 1 * MiB;
constexpr size_t WS_PWT = 1 * MiB;
constexpr size_t WS_SGA = WS_PWT + 512 * 1024;
constexpr size_t WS_SGAS = WS_SGA + 768 * 1024;
constexpr size_t WS_ROWSTAT = 4 * MiB;
constexpr size_t WS_W = 8 * MiB;
constexpr size_t WL_GU1 = 0, WL_D1 = (size_t)NGU * DM, WL_IN = WL_D1 + (size_t)DM * DFF, WL_OUT = WL_IN + (size_t)DIN * DM, WL_GU2 = WL_OUT + (size_t)DM * DM,
                 WL_D2 = WL_GU2 + (size_t)NGU * DM, WL_TOTAL = WL_D2 + (size_t)DM * DFF;
constexpr size_t WS_H = 624 * MiB;
constexpr size_t WS_CAT = 690 * MiB;
constexpr size_t WS_Y = 756 * MiB;
constexpr size_t WS_HID = 888 * MiB;
constexpr size_t WS_Z = WS_HID;
constexpr size_t WS_END = 1070 * MiB;
static_assert(WS_W + 4 * WL_TOTAL * 2 <= WS_H && WS_H + (size_t)M * DM * 2 <= WS_CAT && WS_CAT + (size_t)M * DM * 2 <= WS_Y && WS_Y + (size_t)M * DM * 4 <= WS_HID && WS_HID + (size_t)M * DFF * 2 <= WS_END, "ws map");
static_assert(WS_ROWSTAT + (size_t)M * 12 * 4 <= WS_W && WS_SGAS + 768 * 1024 <= WS_ROWSTAT, "ws map small");
constexpr int CW_TMO = 0, CW_BAR = 4096;
constexpr int RING_OFF = 0, RING_BYTES = 131072, LDSCTL_OFF = RING_BYTES, MISC_OFF = LDSCTL_OFF + 320, LDS_BYTES = 147456;
constexpr int HTB = pg8::HTB;

typedef float f32x2 __attribute__((ext_vector_type(2)));
typedef unsigned u32x2 __attribute__((ext_vector_type(2)));
__device__ __forceinline__ float bf2f(unsigned short b) { return __builtin_bit_cast(float, (unsigned)b << 16); }
__device__ __forceinline__ float bflo(unsigned u) { return __builtin_bit_cast(float, u << 16); }
__device__ __forceinline__ float bfhi(unsigned u) { return __builtin_bit_cast(float, u & 0xffff0000u); }
__device__ __forceinline__ float wave_sum(float v) {
#pragma unroll
    for (int o = 1; o < 64; o <<= 1) v += __shfl_xor(v, o);
    return v;
}

struct Args { const float* in[19]; float* out; unsigned char* ws; int ph_lo, ph_hi; };
struct Frame { LAS unsigned char* lds; volatile LAS unsigned* MISC; gu32* ctl; int vcu, G; };
struct Tid { int tid, lane, wave; };
__device__ __forceinline__ Tid get_tid() { Tid t; t.tid = pg8::opaque_tid(); t.lane = t.tid & 63; t.wave = __builtin_amdgcn_readfirstlane(t.tid >> 6); return t; }

__device__ __forceinline__ void cvt_item(const float* src, int N, int k0, int n0, bf16* dst, int K, int drow0, LAS unsigned short* scr, int lane) {
    f32x4 v[16];
    const float* s = src + (size_t)(k0 + (lane >> 4)) * N + n0 + 4 * (lane & 15);
#pragma unroll
    for (int i = 0; i < 16; ++i) v[i] = *(const f32x4*)(s + (size_t)(4 * i) * N);
#pragma unroll
    for (int i = 0; i < 16; ++i) { const int kl = 4 * i + (lane >> 4), nl = 4 * (lane & 15);
#pragma unroll
        for (int j = 0; j < 4; ++j) scr[(nl + j) * 72 + kl] = (unsigned short)f2bf(v[i][j]); }
    LDS_WAIT(); asm volatile("" ::: "memory");
#pragma unroll
    for (int j = 0; j < 8; ++j) { const int nl = (lane >> 3) + 8 * j, c = lane & 7;
        const v4u o = *(const LAS v4u*)(scr + nl * 72 + 8 * c);
        *(v4u*)(dst + (size_t)(drow0 + nl) * K + k0 + 8 * c) = o; }
    LDS_WAIT(); asm volatile("" ::: "memory");
}
__device__ __forceinline__ void convert_weights(const Frame& F, const Args& a) {
    const Tid t = get_tid();
    LAS unsigned short* scr = (LAS unsigned short*)(F.lds + RING_OFF + t.wave * 9216);
    const int gw = F.vcu * NWAVES + t.wave, NGW = F.G * NWAVES;
    constexpr int IPL = 19712;
    bf16* Wb = (bf16*)(a.ws + WS_W);
    for (int it = gw; it < IPL * DEPTH; it += NGW) {
        const int l = it / IPL; int r = it % IPL; bf16* wl = Wb + (size_t)l * WL_TOTAL;
        const float* src; int N, K; bf16* dst; int kind;
        if (r < 2816)       { src = a.in[5] + (size_t)(l * 2 + 0) * DM * DFF; N = DFF; K = DM; dst = wl + WL_GU1; kind = 1; }
        else if (r < 5632)  { r -= 2816;  src = a.in[6] + (size_t)(l * 2 + 0) * DM * DFF; N = DFF; K = DM; dst = wl + WL_GU1; kind = 2; }
        else if (r < 8448)  { r -= 5632;  src = a.in[7] + (size_t)(l * 2 + 0) * DFF * DM; N = DM; K = DFF; dst = wl + WL_D1; kind = 0; }
        else if (r < 10240) { r -= 8448;  src = a.in[8] + (size_t)l * DM * DIN; N = DIN; K = DM; dst = wl + WL_IN; kind = 3; }
        else if (r < 11264) { r -= 10240; src = a.in[18] + (size_t)l * DM * DM; N = DM; K = DM; dst = wl + WL_OUT; kind = 0; }
        else if (r < 14080) { r -= 11264; src = a.in[5] + (size_t)(l * 2 + 1) * DM * DFF; N = DFF; K = DM; dst = wl + WL_GU2; kind = 1; }
        else if (r < 16896) { r -= 14080; src = a.in[6] + (size_t)(l * 2 + 1) * DM * DFF; N = DFF; K = DM; dst = wl + WL_GU2; kind = 2; }
        else                { r -= 16896; src = a.in[7] + (size_t)(l * 2 + 1) * DFF * DM; N = DM; K = DFF; dst = wl + WL_D2; kind = 0; }
        const int nb = N >> 6, kb = r / nb, cb = r % nb, n0 = cb * 64; int drow0 = n0;
        if (kind == 1) drow0 = 256 * (n0 >> 7) + (n0 & 127);
        else if (kind == 2) drow0 = 256 * (n0 >> 7) + 128 + (n0 & 127);
        else if (kind == 3) { if (n0 >= 2816) drow0 = 2048 + 256 * ((n0 - 2816) >> 7) + 128 + ((n0 - 2816) & 127); else if (n0 >= 2048) drow0 = 2048 + 256 * ((n0 - 2048) >> 7) + ((n0 - 2048) & 127); }
        cvt_item(src, N, kb * 64, n0, dst, K, drow0, scr, t.lane);
    }
}
__device__ __forceinline__ void convert_small(const Frame& F, const Args& a) {
    const Tid t = get_tid();
    const int gt = F.vcu * (NWAVES * 64) + t.tid, NGT = F.G * NWAVES * 64;
    bf16* pwt = (bf16*)(a.ws + WS_PWT); bf16* sga = (bf16*)(a.ws + WS_SGA); bf16* sgas = (bf16*)(a.ws + WS_SGAS);
    for (int e = gt; e < DEPTH * 4 * 16384; e += NGT) { const int c = e & 127, d = (e >> 7) & 127, lg = e >> 14; pwt[e] = (bf16)f2bf(a.in[9][(size_t)lg * 16384 + c * 128 + d]); }
    for (int e = gt; e < DEPTH * 6 * 16384; e += NGT) { const int k = e & 127, q = (e >> 7) & 127, lh = e >> 14;
        sga[e] = (bf16)(k <= q ? f2bf(a.in[12][e]) : 0u);
        const int bq = q >> 5, qq = q & 31, bk = k >> 5, kk = k & 31;
        sgas[e] = (bf16)((bq == bk && kk <= qq) ? f2bf(a.in[12][(size_t)lh * 16384 + qq * 128 + kk]) : 0u); }
}

template <int MODE> __device__ __forceinline__ void norm_phase(const Frame& F, const Args& a, const float* gpost, float scale, const float* gpre) {
    const Tid t = get_tid(); const int lane = t.lane;
    const int gw = F.vcu * NWAVES + t.wave, NGW = F.G * NWAVES;
    float* X = a.out + O_Y; const float* Y = (const float*)(a.ws + WS_Y); bf16* H = (bf16*)(a.ws + WS_H);
    f32x4 gp[8], gq[8];
#pragma unroll
    for (int j = 0; j < 8; ++j) { if (MODE != 0) gp[j] = *((const f32x4*)gpost + lane + 64 * j); if (MODE != 2) gq[j] = *((const f32x4*)gpre + lane + 64 * j); }
    for (int m = gw; m < M; m += NGW) {
        f32x4 xv[8];
        if (MODE == 0) { const float* src = m < SEQ ? a.in[0] + (size_t)m * DM : a.in[1] + (size_t)(m - SEQ) * DM;
#pragma unroll
            for (int j = 0; j < 8; ++j) xv[j] = *((const f32x4*)src + lane + 64 * j);
        } else {
            f32x4 yv[8]; float s = 0.f;
#pragma unroll
            for (int j = 0; j < 8; ++j) { yv[j] = *((const f32x4*)(Y + (size_t)m * DM) + lane + 64 * j); xv[j] = *((const f32x4*)(X + (size_t)m * DM) + lane + 64 * j); }
#pragma unroll
            for (int j = 0; j < 8; ++j) s += (yv[j][0] * yv[j][0] + yv[j][1] * yv[j][1]) + (yv[j][2] * yv[j][2] + yv[j][3] * yv[j][3]);
            const float r = scale / sqrtf(wave_sum(s) * (1.0f / DM) + EPS);
#pragma unroll
            for (int j = 0; j < 8; ++j) xv[j] = xv[j] + (yv[j] * r) * gp[j];
        }
#pragma unroll
        for (int j = 0; j < 8; ++j) *((f32x4*)(X + (size_t)m * DM) + lane + 64 * j) = xv[j];
        if (MODE != 2) {
            float s2 = 0.f;
#pragma unroll
            for (int j = 0; j < 8; ++j) s2 += (xv[j][0] * xv[j][0] + xv[j][1] * xv[j][1]) + (xv[j][2] * xv[j][2] + xv[j][3] * xv[j][3]);
            const float r2 = 1.0f / sqrtf(wave_sum(s2) * (1.0f / DM) + EPS);
#pragma unroll
            for (int j = 0; j < 8; ++j) { const f32x4 o = (xv[j] * r2) * gq[j]; u32x2 w; w.x = pg8::cvt_pk_bf16(o[0], o[1]); w.y = pg8::cvt_pk_bf16(o[2], o[3]);
                *((u32x2*)(H + (size_t)m * DM) + lane + 64 * j) = w; }
        }
    }
}

__device__ __forceinline__ void quad_mma(LAS unsigned char* la, LAS unsigned char* lb, int wr, int wc, int fr, int fq, f32x4 (&acc)[4][2]) {
    const int aoff = pg8::lds_byte(wr * 64 + fr, fq * 8), boff = pg8::lds_byte(wc * 32 + fr, fq * 8);
#pragma unroll
    for (int m = 0; m < 4; ++m)
#pragma unroll
        for (int n = 0; n < 2; ++n) acc[m][n] = (f32x4){0.f, 0.f, 0.f, 0.f};
#pragma unroll
    for (int kb = 0; kb < 2; ++kb) {
        bf16x8 At[4][2], Bf[2][2];
#pragma unroll
        for (int m = 0; m < 4; ++m)
#pragma unroll
            for (int k = 0; k < 2; ++k) At[m][k] = *(const LAS bf16x8*)(la + kb * HTB + aoff + m * 2048 + k * 1024);
#pragma unroll
        for (int n = 0; n < 2; ++n)
#pragma unroll
            for (int k = 0; k < 2; ++k) Bf[n][k] = *(const LAS bf16x8*)(lb + kb * HTB + boff + n * 2048 + k * 1024);
#pragma unroll
        for (int m = 0; m < 4; ++m)
#pragma unroll
            for (int n = 0; n < 2; ++n)
#pragma unroll
                for (int k = 0; k < 2; ++k) acc[m][n] = __builtin_amdgcn_mfma_f32_16x16x32_bf16(Bf[n][k], At[m][k], acc[m][n], 0, 0, 0);
    }
}
__device__ __forceinline__ void stage_image(const bf16* src, LAS unsigned char* img, int tid) {
#pragma unroll
    for (int kb = 0; kb < 2; ++kb)
#pragma unroll
        for (int i = 0; i < 2; ++i) { const int b = tid * 16 + i * 8192; int R, C; pg8::stage_rc(b, R, C);
            *(LAS v4u*)(img + kb * HTB + b) = *(const v4u*)(src + R * 128 + kb * 64 + C); }
}

__device__ __forceinline__ void pool_unit(const Frame& F, const Args& a, int l, int T, int g) {
    LAS unsigned short* PB = (LAS unsigned short*)(F.lds + 0);
    LAS unsigned char* LA = F.lds + 49152; LAS unsigned char* LB = F.lds + 81920;
    const bf16* Z = (const bf16*)(a.ws + WS_Z); bf16* CAT = (bf16*)(a.ws + WS_CAT);
    const Tid t = get_tid(); const int r0 = 128 * T; const bool sample = r0 >= SEQ; const int tid = t.tid;
    __syncthreads();
    stage_image((const bf16*)(a.ws + WS_PWT) + (size_t)(l * 4 + g) * 16384, LB, tid);
    for (int it = tid; it < 4 * 47 * 16; it += NWAVES * 64) {
        const int seg = it / 752, rem = it % 752, rr = rem >> 4, ch = rem & 15;
        v4u val = (v4u){0u, 0u, 0u, 0u};
        if (sample && rr < 15) { const int b = ((r0 - SEQ) >> 5) + seg; const float* s = a.in[2] + ((size_t)(l * DEC_B + b) * 15 + rr) * DPOOL + g * 128 + 8 * ch;
            const f32x4 p0 = *(const f32x4*)s, p1 = *(const f32x4*)(s + 4);
            val.x = pg8::cvt_pk_bf16(p0[0], p0[1]); val.y = pg8::cvt_pk_bf16(p0[2], p0[3]); val.z = pg8::cvt_pk_bf16(p1[0], p1[1]); val.w = pg8::cvt_pk_bf16(p1[2], p1[3]);
        } else { const int row = r0 + 32 * seg + rr - 15; if (row >= 0) val = *(const v4u*)(Z + (size_t)row * ZP + g * 128 + 8 * ch); }
        *(LAS v4u*)(PB + (seg * 47 + rr) * 128 + 8 * ch) = val;
    }
    __syncthreads();
    { const int c = tid & 127, seg = tid >> 7, w = 2 << g;
        for (int tau = 0; tau < 32; ++tau) {
            float s = 0.f; const LAS unsigned short* p = PB + (seg * 47 + 15 + tau) * 128 + c;
            for (int j = 0; j < w; ++j) s += bf2f(p[-j * 128]);
            const int pos1 = r0 + 32 * seg + tau + 1; const int cnt = (sample || pos1 > w) ? w : pos1;
            const float pooled = s / (float)cnt - bf2f(p[0]);
            *(LAS unsigned short*)(LA + (c >> 6) * HTB + pg8::lds_byte(32 * seg + tau, c & 63)) = (unsigned short)f2bf(pooled);
        } }
    __syncthreads();
    const int wr = t.wave >> 2, wc = t.wave & 3, fr = t.lane & 15, fq = t.lane >> 4;
    f32x4 acc[4][2]; quad_mma(LA, LB, wr, wc, fr, fq, acc);
    const float* sc = a.in[10] + l * DPOOL + g * 128;
#pragma unroll
    for (int m = 0; m < 4; ++m)
#pragma unroll
        for (int n = 0; n < 2; ++n) { const int row = r0 + 64 * wr + 16 * m + fr, col = 32 * wc + 16 * n + 4 * fq; const f32x4 s4 = *(const f32x4*)(sc + col), o = acc[m][n] * s4;
            u32x2 w2; w2.x = pg8::cvt_pk_bf16(o[0], o[1]); w2.y = pg8::cvt_pk_bf16(o[2], o[3]); *(u32x2*)(CAT + (size_t)row * DM + g * 128 + col) = w2; }
}

__device__ __forceinline__ void sgu_unit(const Frame& F, const Args& a, int l, int T, int h) {
    LAS unsigned char* LA = F.lds + 0; LAS unsigned char* LB = F.lds + 32768; LAS float* RS = (LAS float*)(F.lds + 65536);
    const bf16* Z = (const bf16*)(a.ws + WS_Z); bf16* CAT = (bf16*)(a.ws + WS_CAT); const float* rowstat = (const float*)(a.ws + WS_ROWSTAT);
    const Tid t = get_tid(); const int r0 = 128 * T; const bool sample = r0 >= SEQ; const int tid = t.tid;
    __syncthreads();
    if (tid < 128) { const f32x4* rs = (const f32x4*)(rowstat + (size_t)(r0 + tid) * 12); const f32x4 s0 = rs[0], s1 = rs[1], s2 = rs[2];
        const float s = ((s0[0] + s0[1]) + (s0[2] + s0[3])) + ((s1[0] + s1[1]) + (s1[2] + s1[3])) + ((s2[0] + s2[1]) + (s2[2] + s2[3]));
        RS[tid] = 1.0f / sqrtf(s * (1.0f / DSGU) + EPS); }
    stage_image((const bf16*)(a.ws + (sample ? WS_SGAS : WS_SGA)) + (size_t)(l * 6 + h) * 16384, LA, tid);
    __syncthreads();
#pragma unroll
    for (int i = 0; i < 4; ++i) { const int it = tid + 512 * i, k = it >> 4, ch = it & 15;
        const v4u gv = *(const v4u*)(Z + (size_t)(r0 + k) * ZP + 1280 + 128 * h + 8 * ch);
        const float r = RS[k]; const float* gp = a.in[11] + l * DSGU + 128 * h + 8 * ch; const f32x4 g0 = *(const f32x4*)gp, g1 = *(const f32x4*)(gp + 4);
        float v[8]; v[0] = bflo(gv.x) * r * g0[0]; v[1] = bfhi(gv.x) * r * g0[1]; v[2] = bflo(gv.y) * r * g0[2]; v[3] = bfhi(gv.y) * r * g0[3];
        v[4] = bflo(gv.z) * r * g1[0]; v[5] = bfhi(gv.z) * r * g1[1]; v[6] = bflo(gv.w) * r * g1[2]; v[7] = bfhi(gv.w) * r * g1[3];
#pragma unroll
        for (int j = 0; j < 8; ++j) *(LAS unsigned short*)(LB + (k >> 6) * HTB + pg8::lds_byte(8 * ch + j, k & 63)) = (unsigned short)f2bf(v[j]);
        if (sample) { const int b = ((r0 - SEQ) >> 5) + (k >> 5), tau = k & 31; float* o = a.out + O_V + ((size_t)(l * DEC_B + b) * DEC_T + tau) * DSGU + 128 * h + 8 * ch;
            *(f32x4*)o = (f32x4){v[0], v[1], v[2], v[3]}; *(f32x4*)(o + 4) = (f32x4){v[4], v[5], v[6], v[7]}; }
    }
    __syncthreads();
    const int wr = t.wave >> 2, wc = t.wave & 3, fr = t.lane & 15, fq = t.lane >> 4;
    f32x4 acc[4][2]; quad_mma(LA, LB, wr, wc, fr, fq, acc);
    const float* sb = a.in[13] + (l * 6 + h) * 128;
#pragma unroll
    for (int m = 0; m < 4; ++m) { const int rl = 64 * wr + 16 * m + fr; const float bias = sb[sample ? (rl & 31) : rl];
#pragma unroll
        for (int n = 0; n < 2; ++n) { const int col = 512 + 128 * h + 32 * wc + 16 * n + 4 * fq; const u32x2 uu = *(const u32x2*)(Z + (size_t)(r0 + rl) * ZP + col);
            const f32x4 o = (f32x4){bflo(uu.x), bfhi(uu.x), bflo(uu.y), bfhi(uu.y)} * (acc[m][n] + bias);
            u32x2 w2; w2.x = pg8::cvt_pk_bf16(o[0], o[1]); w2.y = pg8::cvt_pk_bf16(o[2], o[3]); *(u32x2*)(CAT + (size_t)(r0 + rl) * DM + col) = w2; } }
}

__device__ __forceinline__ void conv_unit(const Frame& F, const Args& a, int l, int U) {
    LAS float* RED = (LAS float*)(F.lds + 0);
    const bf16* Z = (const bf16*)(a.ws + WS_Z); bf16* CAT = (bf16*)(a.ws + WS_CAT);
    const Tid t = get_tid(); const int r0 = 32 * U; const bool sample = r0 >= SEQ; const int tid = t.tid; const bool active = tid < 384; const int ch = active ? 2 * tid : 0;
    __syncthreads();
    unsigned win[62]; f32x2 wv[31];
#pragma unroll
    for (int i = 0; i < 62; ++i) {
        unsigned v = 0u;
        if (sample && i < 30) { const int b = (r0 - SEQ) >> 5; const f32x2 hv = *(const f32x2*)(a.in[3] + ((size_t)(l * DEC_B + b) * 30 + i) * DCONV + ch); v = pg8::cvt_pk_bf16(hv[0], hv[1]); }
        else { const int row = r0 - 30 + i; if (row >= 0) v = *(const unsigned*)(Z + (size_t)row * ZP + 2048 + ch); }
        win[i] = v;
    }
#pragma unroll
    for (int j = 0; j < 31; ++j) wv[j] = *(const f32x2*)(a.in[14] + ((size_t)l * CONVK + j) * DCONV + ch);
    const f32x2 cb = *(const f32x2*)(a.in[15] + l * DCONV + ch), lg = *(const f32x2*)(a.in[16] + l * DCONV + ch), lb = *(const f32x2*)(a.in[17] + l * DCONV + ch);
#pragma unroll
    for (int blk = 0; blk < 4; ++blk) {
        f32x2 y[8];
#pragma unroll
        for (int o = 0; o < 8; ++o) y[o] = cb;
#pragma unroll
        for (int i = 0; i < 38; ++i) { const unsigned u = win[8 * blk + i]; const f32x2 x = (f32x2){bflo(u), bfhi(u)};
#pragma unroll
            for (int o = 0; o < 8; ++o) { const int j = i - o; if (j >= 0 && j < 31) y[o] = y[o] + x * wv[j]; } }
        float st[16];
#pragma unroll
        for (int o = 0; o < 8; ++o) { const float s1 = active ? y[o][0] + y[o][1] : 0.f, s2 = active ? y[o][0] * y[o][0] + y[o][1] * y[o][1] : 0.f; st[2 * o] = wave_sum(s1); st[2 * o + 1] = wave_sum(s2); }
        if (t.lane == 0 && t.wave < 6) {
#pragma unroll
            for (int q = 0; q < 16; ++q) RED[((blk & 1) * 6 + t.wave) * 16 + q] = st[q]; }
        __syncthreads();
#pragma unroll
        for (int o = 0; o < 8; ++o) { float s1 = 0.f, s2 = 0.f;
#pragma unroll
            for (int w = 0; w < 6; ++w) { s1 += RED[((blk & 1) * 6 + w) * 16 + 2 * o]; s2 += RED[((blk & 1) * 6 + w) * 16 + 2 * o + 1]; }
            const float mean = s1 * (1.0f / DCONV), var = s2 * (1.0f / DCONV) - mean * mean, rstd = 1.0f / sqrtf(fmaxf(var, 0.f) + EPS);
            const float z0 = (y[o][0] - mean) * rstd * lg[0] + lb[0], z1 = (y[o][1] - mean) * rstd * lg[1] + lb[1];
            if (active) *(unsigned*)(CAT + (size_t)(r0 + 8 * blk + o) * DM + 1280 + ch) = pg8::cvt_pk_bf16(z0 * pg8::sigmoid_f(z0), z1 * pg8::sigmoid_f(z1)); }
    }
}
__device__ __forceinline__ void state_copy(const Frame& F, const Args& a, int l) {
    const bf16* Z = (const bf16*)(a.ws + WS_Z); const Tid t = get_tid();
    const int gt = F.vcu * (NWAVES * 64) + t.tid, NGT = F.G * NWAVES * 64;
    for (int e = gt; e < 522240; e += NGT) {
        size_t zi, oi;
        if (e < 7680) { const int r = e >> 9, c = e & 511; zi = (size_t)(SEQ - 15 + r) * ZP + c; oi = O_POOLP + (size_t)l * 7680 + e; }
        else if (e < 30720) { const int e2 = e - 7680, r = e2 / 768, c = e2 % 768; zi = (size_t)(SEQ - 30 + r) * ZP + 2048 + c; oi = O_CONVP + (size_t)l * 23040 + e2; }
        else if (e < 153600) { const int e2 = e - 30720, b = e2 / 7680, rem = e2 % 7680, r = rem >> 9, c = rem & 511; zi = (size_t)(SEQ + b * 32 + 17 + r) * ZP + c; oi = O_POOLS + (size_t)(l * DEC_B + b) * 7680 + rem; }
        else { const int e2 = e - 153600, b = e2 / 23040, rem = e2 % 23040, r = rem / 768, c = rem % 768; zi = (size_t)(SEQ + b * 32 + 2 + r) * ZP + 2048 + c; oi = O_CONVS + (size_t)(l * DEC_B + b) * 23040 + rem; }
        a.out[oi] = bf2f(Z[zi]);
    }
}
__device__ __forceinline__ void mixer_phase(const Frame& F, const Args& a, int l) {
    constexpr int NT = M / 128, NSGU = NT * 6, NCONV = M / 32, NPOOL = NT * 4;
    for (int u = F.vcu; u < NSGU; u += F.G) sgu_unit(F, a, l, u / 6, u % 6);
    for (int u = (F.vcu + F.G - (NSGU % 256)) % F.G; u < NCONV; u += F.G) conv_unit(F, a, l, u);
    for (int u = (F.vcu + F.G - ((NSGU + NCONV) % 256)) % F.G; u < NPOOL; u += F.G) pool_unit(F, a, l, u >> 2, u & 3);
    state_copy(F, a, l);
}

__global__ void __launch_bounds__(NWAVES * 64, 2) fwd_kernel(Args args) {
    extern __shared__ __attribute__((aligned(16))) unsigned char lds[];
    Frame F;
    F.lds = (LAS unsigned char*)lds; F.MISC = (volatile LAS unsigned*)(F.lds + MISC_OFF);
    F.G = gridDim.x; { const int bx = blockIdx.x; F.vcu = (F.G % 8 == 0) ? (bx % 8) * (F.G / 8) + bx / 8 : bx; }
    F.ctl = (gu32*)(args.ws + WS_CTL);
    for (int u = threadIdx.x; u < (LDS_BYTES - LDSCTL_OFF) / 4; u += NWAVES * 64) ((LAS unsigned*)(F.lds + LDSCTL_OFF))[u] = 0u;
    __syncthreads();
    XcdBarrier bar; bar.bar = (unsigned*)(F.ctl + CW_BAR); bar.x = 0; bar.st = nullptr;
    if (!MK_MULTI) bar = xcd_barrier_post((unsigned*)(F.ctl + CW_BAR), F.MISC + 8);
    const int lo = args.ph_lo, hi = args.ph_hi;
#define IN(k) (lo <= (k) && (k) < hi)
#define SEAM(k) do { if (IN(k) && IN((k) + 1)) xcd_barrier(bar); } while (0)
    const float* ng = args.in[4];
    bf16* Wb = (bf16*)(args.ws + WS_W); bf16* H = (bf16*)(args.ws + WS_H); bf16* CAT = (bf16*)(args.ws + WS_CAT); bf16* HID = (bf16*)(args.ws + WS_HID); bf16* Z = (bf16*)(args.ws + WS_Z);
    float* Y = (float*)(args.ws + WS_Y); float* rowstat = (float*)(args.ws + WS_ROWSTAT);

    if (IN(0)) { convert_weights(F, args); convert_small(F, args); norm_phase<0>(F, args, nullptr, 0.f, ng); }
    SEAM(0);
    for (int l0 = 0; l0 < DEPTH; ++l0) {
        for (int s0 = 0; s0 < 3; ++s0) {
            int l = l0, s = s0; asm volatile("" : "+s"(l), "+s"(s));
            const bf16* wl = Wb + (size_t)l * WL_TOTAL; const int pb = 1 + 10 * l;
            if (s != 1) {
                const int p0 = pb + (s ? 7 : 0);
                if (IN(p0)) { pg8::Gemm g{H, wl + (s ? WL_GU2 : WL_GU1), M, NGU, DM}; pg8::StaticOrder S; S.init(M, NGU, F.G, (int)blockIdx.x); pg8::EpiSwiGLU E{HID, DFF};
                    pg8::gemm_phase<pg8::EpiSwiGLU, pg8::StaticOrder, true, true>(F.lds + RING_OFF, g, S, E); }
                SEAM(p0);
                if (IN(p0 + 1)) { pg8::Gemm g{HID, wl + (s ? WL_D2 : WL_D1), M, DM, DFF}; pg8::StaticOrder S; S.init(M, DM, F.G, (int)blockIdx.x); pg8::EpiF32Y E{Y, DM};
                    pg8::gemm_phase<pg8::EpiF32Y, pg8::StaticOrder, true, true>(F.lds + RING_OFF, g, S, E); }
                SEAM(p0 + 1);
                if (IN(p0 + 2)) { const float* gpost = ng + (size_t)(l * 6 + (s ? 5 : 1)) * DM;
                    if (s == 0) norm_phase<1>(F, args, gpost, 0.5f, ng + (size_t)(l * 6 + 2) * DM);
                    else if (l + 1 < DEPTH) norm_phase<1>(F, args, gpost, 0.5f, ng + (size_t)((l + 1) * 6 + 0) * DM);
                    else norm_phase<2>(F, args, gpost, 0.5f, nullptr); }
                SEAM(p0 + 2);
            } else {
                const int p0 = pb + 3;
                if (IN(p0)) { pg8::Gemm g{H, wl + WL_IN, M, DIN, DM}; pg8::StaticOrder S; S.init(M, DIN, F.G, (int)blockIdx.x); pg8::EpiWin E{Z, ZP, rowstat};
                    pg8::gemm_phase<pg8::EpiWin, pg8::StaticOrder, true, true>(F.lds + RING_OFF, g, S, E); }
                SEAM(p0);
                if (IN(p0 + 1)) mixer_phase(F, args, l);
                SEAM(p0 + 1);
                if (IN(p0 + 2)) { pg8::Gemm g{CAT, wl + WL_OUT, M, DM, DM}; pg8::StaticOrder S; S.init(M, DM, F.G, (int)blockIdx.x); pg8::EpiF32Y E{Y, DM};
                    pg8::gemm_phase<pg8::EpiF32Y, pg8::StaticOrder, true, true>(F.lds + RING_OFF, g, S, E); }
                SEAM(p0 + 2);
                if (IN(p0 + 3)) norm_phase<1>(F, args, ng + (size_t)(l * 6 + 3) * DM, 1.0f, ng + (size_t)(l * 6 + 4) * DM);
                SEAM(p0 + 3);
            }
        }
    }
#undef IN
#undef SEAM
}

extern "C" void kernel_launch(void* const* d_in, const int* in_sizes, int n_in, void* d_out, int out_size, void* d_ws, size_t ws_size, hipStream_t stream) {
    static int grid = 0;
    if (grid == 0) {
        if (n_in != 19 || (size_t)out_size != O_END || ws_size < WS_END) { fprintf(stderr, "kernel_launch: unexpected sizes: n_in %d out %d ws %zu (need %zu)\n", n_in, out_size, ws_size, (size_t)WS_END); grid = -1; return; }
        int dev = 0, cus = 0, per_cu = 0;
        if (hipGetDevice(&dev) != hipSuccess || hipDeviceGetAttribute(&cus, hipDeviceAttributeMultiprocessorCount, dev) != hipSuccess) { grid = -1; return; }
        if (hipFuncSetAttribute((const void*)fwd_kernel, hipFuncAttributeMaxDynamicSharedMemorySize, LDS_BYTES) != hipSuccess) { fprintf(stderr, "kernel_launch: hipFuncSetAttribute failed\n"); grid = -1; return; }
        if (hipOccupancyMaxActiveBlocksPerMultiprocessor(&per_cu, (const void*)fwd_kernel, NWAVES * 64, LDS_BYTES) != hipSuccess || per_cu < 1) fprintf(stderr, "kernel_launch: occupancy query says %d\n", per_cu);
        (void)hipGetLastError();
        grid = cus;
    }
    if (grid < 0) return;
    (void)hipMemsetAsync((char*)d_ws + WS_CTL, 0, CTL_ZERO_BYTES, stream);
    Args a{};
    for (int i = 0; i < 19; ++i) a.in[i] = (const float*)d_in[i];
    a.out = (float*)d_out; a.ws = (unsigned char*)d_ws;
#if MK_MULTI
    for (int p = 0; p < NPHASE; ++p) { a.ph_lo = p; a.ph_hi = p + 1; hipLaunchKernelGGL(fwd_kernel, dim3(grid), dim3(NWAVES * 64), LDS_BYTES, stream, a); }
#else
    a.ph_lo = 0; a.ph_hi = NPHASE; hipLaunchKernelGGL(fwd_kernel, dim3(grid), dim3(NWAVES * 64), LDS_BYTES, stream, a);
#endif
}
```

```cpp
#include <hip/hip_runtime.h>
#include <cstdio>
#include <cstdint>
#define MK_MULTI 0
namespace pg8 {
#define PG8_LAS __attribute__((address_space(3)))
typedef unsigned short bf16_t;
typedef short bf16x8 __attribute__((ext_vector_type(8)));
typedef float f32x4 __attribute__((ext_vector_type(4)));
typedef unsigned u32x4 __attribute__((ext_vector_type(4)));
constexpr int BM = 256, BK = 64, HALF = 128, HTB = HALF * BK * 2  , STAGE_BYTES = 8 * HTB, NXCD = 8, WGM = 8;

__host__ __device__ __forceinline__ int lds_byte(int r, int c) { const int st = (r >> 4) * 2 + (c >> 5), rr = r & 15, cc = c & 31, ob = rr * 64 + cc * 2; return st * 1024 + (ob ^ (((ob >> 9) & 1) << 5)); }
__host__ __device__ __forceinline__ void stage_rc(int b, int& R, int& C) { const int st = b / 1024, sb = b % 1024, swz = sb ^ (((sb >> 9) & 1) << 5); R = (st >> 1) * 16 + swz / 64; C = (st & 1) * 32 + (swz % 64) / 2; }
__host__ __device__ __forceinline__ int perm32(int rho) { const int n = rho >> 4, i = rho & 15; return 8 * (i >> 2) + 4 * n + (i & 3); }

__device__ __forceinline__ int opaque_tid() { int t = threadIdx.x; asm volatile("" : "+v"(t)); return t; }
struct Unit { int pm, pn, koff, aux; };
struct Gemm { const bf16_t* A; const bf16_t* Bt; int M, N, K, ld; };

struct StaticOrder {
    int nM, nN, nwg, G, c;
    __host__ __device__ void init(int M, int N, int G_, int c_) { nM = M / BM; nN = N / BM; nwg = nM * nN; G = G_; c = c_; }
    __host__ __device__ bool next(int i, Unit& u) const {
        const long L = (long)i * G + c; if (L >= nwg) return false;
        int wgid = (int)L; { const int q = nwg / NXCD, r = nwg % NXCD, xcd = wgid % NXCD, off = wgid / NXCD; wgid = (xcd < r ? xcd * (q + 1) : r * (q + 1) + (xcd - r) * q) + off; }
        const int nig = WGM * nN, gid = wgid / nig, fm = gid * WGM, gsz = (nM - fm) < WGM ? (nM - fm) : WGM;
        u.pm = fm + ((wgid % nig) % gsz); u.pn = (wgid % nig) / gsz; u.koff = 0; u.aux = 0; return true;
    }
    __device__ __forceinline__ void a_ready(const Unit&) const {}
    __device__ __forceinline__ void done(const Unit&) const {}
};
__device__ __forceinline__ unsigned cvt_pk_bf16(float lo, float hi) { unsigned r; asm volatile("v_cvt_pk_bf16_f32 %0, %1, %2" : "=v"(r) : "v"(lo), "v"(hi)); return r; }
typedef float f32x2 __attribute__((ext_vector_type(2)));
__device__ __forceinline__ f32x2 gelu_pk(f32x2 v) {
    const f32x2 av = __builtin_elementwise_abs(v), d = av * 0.2316418882f + 1.0f;
    f32x2 t; t.x = __builtin_amdgcn_rcpf(d.x); t.y = __builtin_amdgcn_rcpf(d.y);
    f32x2 q = t * 0.5307027145f + (-0.7265760135f); q = q * t + 0.7107068705f; q = q * t + (-0.142248368f); q = q * t + 0.127414796f; q = q * t;
    const f32x2 s = (v * v) * (-0.72134752044f);
    f32x2 e; e.x = __builtin_amdgcn_exp2f(s.x); e.y = __builtin_amdgcn_exp2f(s.y);
    const f32x2 m = v * (q * e), r = v - m;
    f32x2 o; o.x = v.x < 0.f ? m.x : r.x; o.y = v.y < 0.f ? m.y : r.y; return o;
}
__device__ __forceinline__ float sigmoid_f(float x) { return __builtin_amdgcn_rcpf(1.0f + __builtin_amdgcn_exp2f(x * -1.44269504089f)); }
struct EpiF32Y {
    static constexpr bool PERM = false, AFTER_DRAIN = false;
    float* C; int ldc; int row_sub; size_t aux_stride;
    __device__ __forceinline__ void operator()(const f32x4 (&acc)[2][2][4][2], const Unit& u, int wr, int wc, int fr, int fq) const {
        const int row0 = u.pm * BM - row_sub + wr * 64 + fr, col0 = u.pn * BM + wc * 32 + 4 * fq; float* base = C + (size_t)u.aux * aux_stride;
#pragma unroll
        for (int ai = 0; ai < 2; ++ai)
#pragma unroll
            for (int m = 0; m < 4; ++m) { float* rowp = base + (size_t)(row0 + ai * HALF + m * 16) * ldc + col0;
#pragma unroll
                for (int bj = 0; bj < 2; ++bj)
#pragma unroll
                    for (int n = 0; n < 2; ++n) *(f32x4*)(rowp + bj * HALF + n * 16) = acc[ai][bj][m][n]; }
    }
};
struct EpiBf16Y {
    static constexpr bool PERM = true, AFTER_DRAIN = false;
    bf16_t* O; int ldc;
    __device__ __forceinline__ void operator()(const f32x4 (&acc)[2][2][4][2], const Unit& u, int wr, int wc, int fr, int fq) const {
        const int row0 = u.pm * BM + wr * 64 + fr, col0 = u.pn * BM + wc * 32 + 8 * fq;
#pragma unroll
        for (int ai = 0; ai < 2; ++ai)
#pragma unroll
            for (int m = 0; m < 4; ++m) { bf16_t* rowp = O + (size_t)(row0 + ai * HALF + m * 16) * ldc + col0;
#pragma unroll
                for (int bj = 0; bj < 2; ++bj) { const f32x4 v0 = acc[ai][bj][m][0], v1 = acc[ai][bj][m][1];
                    u32x4 w; w.x = cvt_pk_bf16(v0[0], v0[1]); w.y = cvt_pk_bf16(v0[2], v0[3]); w.z = cvt_pk_bf16(v1[0], v1[1]); w.w = cvt_pk_bf16(v1[2], v1[3]);
                    *(u32x4*)(rowp + bj * HALF) = w; } }
    }
};
struct SplitKOrder {
    int nsub, G, c, npn, pm0, kbytes;
    __device__ __forceinline__ bool next(int i, Unit& u) const { const int j = i * G + c; if (j >= nsub) return false; const int per = 2 * npn, ks = j / per, r = j % per;
        u.pm = pm0 + r / npn; u.pn = r % npn; u.koff = ks * kbytes; u.aux = ks; return true; }
    __device__ __forceinline__ void a_ready(const Unit&) const {}
    __device__ __forceinline__ void done(const Unit&) const {}
};
struct EpiSwiGLU {
    static constexpr bool PERM = true, AFTER_DRAIN = false;
    bf16_t* O; int ldc;
    __device__ __forceinline__ void operator()(const f32x4 (&acc)[2][2][4][2], const Unit& u, int wr, int wc, int fr, int fq) const {
        const int row0 = u.pm * BM + wr * 64 + fr, col0 = u.pn * HALF + wc * 32 + 8 * fq;
#pragma unroll
        for (int ai = 0; ai < 2; ++ai)
#pragma unroll
            for (int m = 0; m < 4; ++m) { bf16_t* rowp = O + (size_t)(row0 + ai * HALF + m * 16) * ldc + col0;
                float h[8];
#pragma unroll
                for (int n = 0; n < 2; ++n)
#pragma unroll
                    for (int j = 0; j < 4; ++j) { const float g = acc[ai][0][m][n][j], up = acc[ai][1][m][n][j]; h[4 * n + j] = g * sigmoid_f(g) * up; }
                u32x4 w; w.x = cvt_pk_bf16(h[0], h[1]); w.y = cvt_pk_bf16(h[2], h[3]); w.z = cvt_pk_bf16(h[4], h[5]); w.w = cvt_pk_bf16(h[6], h[7]);
                *(u32x4*)rowp = w; }
    }
};
struct EpiWin {
    static constexpr bool PERM = true, AFTER_DRAIN = false;
    bf16_t* Z; int ldc; float* rowstat;
    __device__ __forceinline__ void operator()(const f32x4 (&acc)[2][2][4][2], const Unit& u, int wr, int wc, int fr, int fq) const {
        const int row0 = u.pm * BM + wr * 64 + fr; const int pn = u.pn;
        if (pn < 8) {
            const int col0 = pn * BM + wc * 32 + 8 * fq; const bool act = pn >= 2, stat = pn >= 5;
#pragma unroll
            for (int ai = 0; ai < 2; ++ai)
#pragma unroll
                for (int m = 0; m < 4; ++m) { const int row = row0 + ai * HALF + m * 16; bf16_t* rowp = Z + (size_t)row * ldc + col0; float ss = 0.f;
#pragma unroll
                    for (int bj = 0; bj < 2; ++bj) { f32x4 v0 = acc[ai][bj][m][0], v1 = acc[ai][bj][m][1];
                        if (act) { f32x2 a = gelu_pk((f32x2){v0[0], v0[1]}), b = gelu_pk((f32x2){v0[2], v0[3]}), c = gelu_pk((f32x2){v1[0], v1[1]}), d = gelu_pk((f32x2){v1[2], v1[3]});
                            v0 = (f32x4){a.x, a.y, b.x, b.y}; v1 = (f32x4){c.x, c.y, d.x, d.y}; }
                        ss += (v0[0] * v0[0] + v0[1] * v0[1]) + (v0[2] * v0[2] + v0[3] * v0[3]) + (v1[0] * v1[0] + v1[1] * v1[1]) + (v1[2] * v1[2] + v1[3] * v1[3]);
                        u32x4 w; w.x = cvt_pk_bf16(v0[0], v0[1]); w.y = cvt_pk_bf16(v0[2], v0[3]); w.z = cvt_pk_bf16(v1[0], v1[1]); w.w = cvt_pk_bf16(v1[2], v1[3]);
                        *(u32x4*)(rowp + bj * HALF) = w; }
                    if (stat) { ss += __shfl_xor(ss, 16); ss += __shfl_xor(ss, 32); if (fq == 0) rowstat[(size_t)row * 12 + (pn - 5) * 4 + wc] = ss; } }
        } else {
            const int col0 = 2048 + (pn - 8) * HALF + wc * 32 + 8 * fq;
#pragma unroll
            for (int ai = 0; ai < 2; ++ai)
#pragma unroll
                for (int m = 0; m < 4; ++m) { bf16_t* rowp = Z + (size_t)(row0 + ai * HALF + m * 16) * ldc + col0;
                    float h[8];
#pragma unroll
                    for (int n = 0; n < 2; ++n)
#pragma unroll
                        for (int j = 0; j < 4; ++j) h[4 * n + j] = acc[ai][0][m][n][j] * sigmoid_f(acc[ai][1][m][n][j]);
                    u32x4 w; w.x = cvt_pk_bf16(h[0], h[1]); w.y = cvt_pk_bf16(h[2], h[3]); w.z = cvt_pk_bf16(h[4], h[5]); w.w = cvt_pk_bf16(h[6], h[7]);
                    *(u32x4*)rowp = w; }
        }
    }
};
template <class Epi, class Sched, bool ALIGN_EPI = false, bool SP2 = false>
__device__ __forceinline__ void gemm_phase(PG8_LAS unsigned char* lds, const Gemm g, const Sched& S, const Epi& E) {
    const int tid = opaque_tid(), wid = __builtin_amdgcn_readfirstlane(tid >> 6), lane = tid & 63, wr = wid >> 2, wc = wid & 3, fr = lane & 15, fq = lane >> 4;
    const int K = g.K, LD = g.ld, nt = K / BK;
    unsigned voffA[2], voffB[2];
#pragma unroll
    for (int i = 0; i < 2; ++i) { int R, C; stage_rc(tid * 16 + i * 8192, R, C); const int Rb = Epi::PERM ? ((R & ~31) + perm32(R & 31)) : R;
        voffA[i] = (unsigned)(R * LD + C) * 2u; voffB[i] = (unsigned)(Rb * LD + C) * 2u; }
    const size_t kstep = (size_t)(BK * 2);
    const size_t hstep = (size_t)HALF * LD * 2;
    const size_t tstep = 2 * hstep;
    const unsigned ldsw = (unsigned)wid * 1024u;
    const int aoff = lds_byte(wr * 64 + fr, fq * 8), boff = lds_byte(wc * 32 + fr, fq * 8);
#define PG8_SA(b, h) (((b) * 2 + (h)) * HTB)
#define PG8_SB(b, h) ((4 + (b) * 2 + (h)) * HTB)
#define PG8_STAGE(bufoff, gbase, voff) do { _Pragma("unroll") for (int _i = 0; _i < 2; ++_i) \
        __builtin_amdgcn_global_load_lds((const unsigned*)((const char*)(gbase) + (voff)[_i]), (PG8_LAS unsigned*)(lds + (bufoff) + ldsw + _i * 8192), 16, 0, 0); } while (0)
#define PG8_LDA(dst, b, h) do { _Pragma("unroll") for (int m = 0; m < 4; ++m) _Pragma("unroll") for (int k = 0; k < 2; ++k) dst[m][k] = *(const PG8_LAS bf16x8*)(lds + PG8_SA(b, h) + aoff + m * 2048 + k * 1024); } while (0)
#define PG8_LDB(dst, b, h) do { _Pragma("unroll") for (int n = 0; n < 2; ++n) _Pragma("unroll") for (int k = 0; k < 2; ++k) dst[n][k] = *(const PG8_LAS bf16x8*)(lds + PG8_SB(b, h) + boff + n * 2048 + k * 1024); } while (0)
#define PG8_MMA(ai, bj, At, Bt) do { __builtin_amdgcn_s_setprio(1); _Pragma("unroll") for (int m = 0; m < 4; ++m) _Pragma("unroll") for (int n = 0; n < 2; ++n) _Pragma("unroll") for (int k = 0; k < 2; ++k) \
        acc[ai][bj][m][n] = __builtin_amdgcn_mfma_f32_16x16x32_bf16(Bt[n][k], At[m][k], acc[ai][bj][m][n], 0, 0, 0); __builtin_amdgcn_s_setprio(0); } while (0)
#define PG8_WAIT_V(n) asm volatile("s_waitcnt vmcnt(" #n ")" ::: "memory")
#define PG8_WAIT_L(n) asm volatile("s_waitcnt lgkmcnt(" #n ")" ::: "memory")
#define PG8_BAR __builtin_amdgcn_s_barrier()
#define PG8_SCHED __builtin_amdgcn_sched_barrier(0)
    Unit cur, nxt; int ui = 0;
    if (!S.next(0, cur)) return;
    f32x4 acc[2][2][4][2];
#pragma unroll
    for (int a = 0; a < 2; ++a)
#pragma unroll
        for (int b = 0; b < 2; ++b)
#pragma unroll
            for (int m = 0; m < 4; ++m)
#pragma unroll
                for (int n = 0; n < 2; ++n) acc[a][b][m][n] = (f32x4){0.f, 0.f, 0.f, 0.f};
    bf16x8 At[4][2], B0[2][2], B1[2][2];
    const char* cA = (const char*)g.A + (size_t)cur.pm * tstep + cur.koff; const char* cB = (const char*)g.Bt + (size_t)cur.pn * tstep + cur.koff;
    S.a_ready(cur);
    if constexpr (SP2) {
        PG8_STAGE(PG8_SB(0, 0), cB, voffB); PG8_STAGE(PG8_SB(0, 1), cB + hstep, voffB); PG8_STAGE(PG8_SA(0, 0), cA, voffA); PG8_STAGE(PG8_SA(0, 1), cA + hstep, voffA);
        if (wr == 1) PG8_BAR;
        PG8_WAIT_V(2); PG8_BAR;
        PG8_STAGE(PG8_SB(1, 0), cB + kstep, voffB); PG8_STAGE(PG8_SA(1, 0), cA + kstep, voffA); PG8_STAGE(PG8_SB(1, 1), cB + hstep + kstep, voffB);
        PG8_WAIT_V(6); PG8_BAR;
    } else {
        PG8_STAGE(PG8_SB(0, 0), cB, voffB); PG8_STAGE(PG8_SA(0, 0), cA, voffA); PG8_STAGE(PG8_SB(0, 1), cB + hstep, voffB); PG8_STAGE(PG8_SA(0, 1), cA + hstep, voffA);
        if (wr == 1) PG8_BAR;
        PG8_WAIT_V(4); PG8_BAR;
        PG8_STAGE(PG8_SB(1, 0), cB + kstep, voffB); PG8_STAGE(PG8_SA(1, 0), cA + kstep, voffA); PG8_STAGE(PG8_SB(1, 1), cB + hstep + kstep, voffB);
        PG8_WAIT_V(6); PG8_BAR;
    }
    for (;;) {
        const bool has_next = S.next(ui + 1, nxt);
        const char* nA = has_next ? (const char*)g.A + (size_t)nxt.pm * tstep + nxt.koff : cA; const char* nB = has_next ? (const char*)g.Bt + (size_t)nxt.pn * tstep + nxt.koff : cB;
        for (int t = 0; t < nt; t += 2) {
            const bool last = (t == nt - 2);
            const char* a1 = cA + (size_t)(t + 1) * kstep;
            const char* a2 = last ? nA : cA + (size_t)(t + 2) * kstep; const char* b2 = last ? nB : cB + (size_t)(t + 2) * kstep;
            const char* a3 = a2 + kstep; const char* b3 = b2 + kstep;
            if (last && has_next) S.a_ready(nxt);
            if constexpr (SP2) {
            PG8_LDB(B0, 0, 0); PG8_LDB(B1, 0, 1); PG8_SCHED; PG8_LDA(At, 0, 0); PG8_STAGE(PG8_SA(1, 1), a1 + hstep, voffA);
            PG8_WAIT_V(8); PG8_WAIT_L(0); PG8_BAR; PG8_MMA(0, 0, At, B0); PG8_MMA(0, 1, At, B1); PG8_BAR; PG8_SCHED;
            PG8_LDA(At, 0, 1); PG8_STAGE(PG8_SB(0, 0), b2, voffB); PG8_STAGE(PG8_SB(0, 1), b2 + hstep, voffB); PG8_STAGE(PG8_SA(0, 0), a2, voffA);
            PG8_WAIT_V(8); PG8_WAIT_L(0); PG8_BAR; PG8_MMA(1, 0, At, B0); PG8_MMA(1, 1, At, B1); PG8_BAR; PG8_SCHED;
            PG8_LDB(B0, 1, 0); PG8_LDB(B1, 1, 1); PG8_SCHED; PG8_LDA(At, 1, 0); PG8_STAGE(PG8_SA(0, 1), a2 + hstep, voffA);
            PG8_WAIT_V(8); PG8_WAIT_L(0); PG8_BAR; PG8_MMA(0, 0, At, B0); PG8_MMA(0, 1, At, B1); PG8_BAR; PG8_SCHED;
            PG8_LDA(At, 1, 1); PG8_STAGE(PG8_SB(1, 0), b3, voffB); PG8_STAGE(PG8_SB(1, 1), b3 + hstep, voffB); PG8_STAGE(PG8_SA(1, 0), a3, voffA);
            PG8_WAIT_V(8); PG8_WAIT_L(0); PG8_BAR; PG8_MMA(1, 0, At, B0); PG8_MMA(1, 1, At, B1); PG8_BAR; PG8_SCHED;
            } else {
            PG8_LDB(B0, 0, 0); PG8_SCHED; PG8_LDA(At, 0, 0); PG8_STAGE(PG8_SA(1, 1), a1 + hstep, voffA);
            PG8_WAIT_L(8); PG8_BAR; PG8_WAIT_L(0); PG8_MMA(0, 0, At, B0); PG8_BAR; PG8_SCHED;
            PG8_LDB(B1, 0, 1); PG8_STAGE(PG8_SB(0, 0), b2, voffB);
            PG8_BAR; PG8_WAIT_L(0); PG8_MMA(0, 1, At, B1); PG8_BAR;
            PG8_LDA(At, 0, 1); PG8_STAGE(PG8_SA(0, 0), a2, voffA);
            PG8_BAR; PG8_WAIT_L(0); PG8_MMA(1, 0, At, B0); PG8_BAR; PG8_SCHED;
            PG8_STAGE(PG8_SB(0, 1), b2 + hstep, voffB);
            PG8_WAIT_V(6); PG8_BAR; PG8_MMA(1, 1, At, B1); PG8_BAR;
            PG8_LDB(B0, 1, 0); PG8_SCHED; PG8_LDA(At, 1, 0); PG8_STAGE(PG8_SA(0, 1), a2 + hstep, voffA);
            PG8_WAIT_L(8); PG8_BAR; PG8_WAIT_L(0); PG8_MMA(0, 0, At, B0); PG8_BAR; PG8_SCHED;
            PG8_LDB(B1, 1, 1); PG8_STAGE(PG8_SB(1, 0), b3, voffB);
            PG8_BAR; PG8_WAIT_L(0); PG8_MMA(0, 1, At, B1); PG8_BAR;
            PG8_LDA(At, 1, 1); PG8_STAGE(PG8_SA(1, 0), a3, voffA);
            PG8_BAR; PG8_WAIT_L(0); PG8_MMA(1, 0, At, B0); PG8_BAR; PG8_SCHED;
            PG8_STAGE(PG8_SB(1, 1), b3 + hstep, voffB);
            PG8_WAIT_V(6); PG8_BAR; PG8_MMA(1, 1, At, B1); PG8_BAR;
            }
        }
        if constexpr (ALIGN_EPI) { if (wr == 0) PG8_BAR; }
        if constexpr (!Epi::AFTER_DRAIN) { E(acc, cur, wr, wc, fr, fq); S.done(cur); }
        if (!has_next) break;
#pragma unroll
        for (int a = 0; a < 2; ++a)
#pragma unroll
            for (int b = 0; b < 2; ++b)
#pragma unroll
                for (int m = 0; m < 4; ++m)
#pragma unroll
                    for (int n = 0; n < 2; ++n) acc[a][b][m][n] = (f32x4){0.f, 0.f, 0.f, 0.f};
        cur = nxt; cA = nA; cB = nB; ++ui;
        if constexpr (ALIGN_EPI) { if (wr == 1) PG8_BAR; }
    }
    PG8_WAIT_V(0);
    if constexpr (!ALIGN_EPI) { if (wr == 0) PG8_BAR; }
    PG8_BAR;
    if constexpr (Epi::AFTER_DRAIN) { E.fused(acc, cur, wr, wc, fr, fq, lds, wid, lane); S.done(cur); }
#undef PG8_SA
#undef PG8_SB
#undef PG8_STAGE
#undef PG8_LDA
#undef PG8_LDB
#undef PG8_MMA
#undef PG8_WAIT_V
#undef PG8_WAIT_L
#undef PG8_BAR
#undef PG8_SCHED
}
}
#define GAS __attribute__((address_space(1)))
#define LAS __attribute__((address_space(3)))
typedef unsigned short bf16;
typedef unsigned v4u __attribute__((ext_vector_type(4)));
typedef float f32x4 __attribute__((ext_vector_type(4)));
typedef short bf16x8 __attribute__((ext_vector_type(8)));
typedef GAS unsigned gu32;
typedef GAS unsigned long long gu64;
#define RLX_AGENT __ATOMIC_RELAXED, __HIP_MEMORY_SCOPE_AGENT
#define LDS_WAIT() asm volatile("s_waitcnt lgkmcnt(0)" ::: "memory")
#define VM_WAIT() asm volatile("s_waitcnt vmcnt(0)" ::: "memory")
__device__ __forceinline__ unsigned long long rt() { return __builtin_amdgcn_s_memrealtime(); }
__device__ __forceinline__ unsigned f2bf(float f) { unsigned u = __builtin_bit_cast(unsigned, f); return (u + 0x7fffu + ((u >> 16) & 1u)) >> 16; }
__device__ __forceinline__ unsigned pk2(float lo, float hi) { return f2bf(lo) | (f2bf(hi) << 16); }

#define XB_TMO      128
#define XB_XCNT(j)  (256  + 64 * (j))
#define XB_XSUB(j)  (1280 + 64 * (j))
#define XB_XGEN(j)  (2304 + 64 * (j))
#define XB_TOP      3328
#define XB_TOPGEN   3392
#define XCD_BAR_WORDS 3456
#define XB_SPIN_CAP (1u << 18)

__device__ __forceinline__ unsigned xb_ld(unsigned* p)              { return __hip_atomic_load(p, __ATOMIC_RELAXED, __HIP_MEMORY_SCOPE_AGENT); }
__device__ __forceinline__ unsigned xb_add(unsigned* p, unsigned v) { return __hip_atomic_fetch_add(p, v, __ATOMIC_RELAXED, __HIP_MEMORY_SCOPE_AGENT); }
__device__ __forceinline__ unsigned xb_xcc_id() { return (unsigned)__builtin_amdgcn_s_getreg((3 << 11) | 20) & 0xFu; }
#define XB_SPIN(cond, bar) do { unsigned _sp = 0; while (cond) { __builtin_amdgcn_s_sleep(1); \
    if ((++_sp & 255u) == 0u) { if (xb_ld(&(bar)[XB_TMO])) break; if (_sp > XB_SPIN_CAP) { atomicAdd(&(bar)[XB_TMO], 1u); break; } } } } while (0)

struct XcdBarrier {
    unsigned* bar; unsigned x;
    volatile LAS unsigned* st;
};

__device__ __forceinline__ XcdBarrier xcd_barrier_post(unsigned* bar, volatile LAS unsigned* st) {
    XcdBarrier b; b.bar = bar; b.x = xb_xcc_id(); b.st = st;
    if (threadIdx.x == 0) (void)xb_add(&bar[XB_XCNT(b.x)], 1u);
    return b;
}
__device__ __forceinline__ void xcd_barrier_complete(unsigned* bar, unsigned x, unsigned& nloc, unsigned& nx) {
    const unsigned G = gridDim.x * gridDim.y * gridDim.z;
    unsigned sum, cnt, mine, sp = 0u;
    for (;;) {
        sum = 0u; cnt = 0u; mine = 0u;
#pragma unroll
        for (unsigned j = 0; j < 16; ++j) { const unsigned c = xb_ld(&bar[XB_XCNT(j)]); sum += c; cnt += (c > 0u) ? 1u : 0u; mine = (j == x) ? c : mine; }
        if (sum == G) break;
        __builtin_amdgcn_s_sleep(1);
        if ((++sp & 255u) == 0u) { if (xb_ld(&bar[XB_TMO])) break; if (sp > XB_SPIN_CAP) { atomicAdd(&bar[XB_TMO], 1u); break; } }
    }
    nloc = mine > 0u ? mine : 1u; nx = cnt > 0u ? cnt : 1u;
}

__device__ __forceinline__ void xcd_barrier(const XcdBarrier& b) {
    asm volatile("s_waitcnt vmcnt(0)" ::: "memory");
    __syncthreads();
    if (threadIdx.x == 0) {
        unsigned* bar = b.bar;
        __builtin_amdgcn_s_waitcnt(0);
        unsigned nloc = b.st[0], nx = b.st[1];
        if (nloc == 0u) { xcd_barrier_complete(bar, b.x, nloc, nx); b.st[0] = nloc; b.st[1] = nx; }
        const unsigned old = xb_add(&bar[XB_XSUB(b.x)], 1u);
        const unsigned gen = old / nloc;
        if (old + 1u == (gen + 1u) * nloc) {
            __builtin_amdgcn_fence(__ATOMIC_RELEASE, "agent");
            asm volatile("s_waitcnt vmcnt(0)" ::: "memory");
            const unsigned og = xb_add(&bar[XB_TOP], 1u);
            const unsigned tg = og / nx;
            if (og + 1u == (tg + 1u) * nx) xb_add(&bar[XB_TOPGEN], 1u);
            else XB_SPIN(xb_ld(&bar[XB_TOPGEN]) == tg, bar);
            __builtin_amdgcn_fence(__ATOMIC_ACQUIRE, "agent");
            xb_add(&bar[XB_XGEN(b.x)], 1u);
            asm volatile("s_waitcnt vmcnt(0)" ::: "memory");
        } else {
            XB_SPIN(xb_ld(&bar[XB_XGEN(b.x)]) == gen, bar);
            __builtin_amdgcn_fence(__ATOMIC_ACQUIRE, "agent");
            asm volatile("s_waitcnt vmcnt(0)" ::: "memory");
        }
    }
    __syncthreads();
}
constexpr int NWAVES = 8;
constexpr int DM = 2048, SEQ = 16384, DEPTH = 4, DEC_B = 16, DEC_T = 32, MS = DEC_B * DEC_T, M = SEQ + MS;
constexpr int DFF = 5632, DIN = 3584, DPOOL = 512, DSGU = 768, DCONV = 768, CONVK = 31, ZP = 2816;
constexpr int NGU = 2 * DFF;
constexpr float EPS = 1e-6f;
#ifndef MK_MULTI
#define MK_MULTI 0
#endif
constexpr int NPHASE = 1 + 10 * DEPTH;
#ifndef PR_CVT
#define PR_CVT 1
#endif
#ifndef PR_MIX
#define PR_MIX 1
#endif
#ifndef PR_GU
#define PR_GU 1
#endif
#ifndef PR_D
#define PR_D 1
#endif
#ifndef PR_WIN
#define PR_WIN 1
#endif
constexpr size_t O_Y = 0, O_POOLP = (size_t)M * DM, O_CONVP = O_POOLP + (size_t)DEPTH * 15 * DPOOL, O_POOLS = O_CONVP + (size_t)DEPTH * 30 * DCONV,
                 O_CONVS = O_POOLS + (size_t)DEPTH * DEC_B * 15 * DPOOL, O_V = O_CONVS + (size_t)DEPTH * DEC_B * 30 * DCONV, O_END = O_V + (size_t)DEPTH * DEC_B * DEC_T * DSGU;
constexpr size_t MiB = 1u << 20;
constexpr size_t WS_CTL = 0, CTL_ZERO_BYTES = 1 * MiB;
constexpr size_t WS_PWT = 1 * MiB;
constexpr size_t WS_SGA = WS_PWT + 512 * 1024;
constexpr size_t WS_SGAS = WS_SGA + 768 * 1024;
constexpr size_t WS_ROWSTAT = 4 * MiB;
constexpr size_t WS_W = 8 * MiB;
constexpr size_t WL_GU1 = 0, WL_D1 = (size_t)NGU * DM, WL_IN = WL_D1 + (size_t)DM * DFF, WL_OUT = WL_IN + (size_t)DIN * DM, WL_GU2 = WL_OUT + (size_t)DM * DM,
                 WL_D2 = WL_GU2 + (size_t)NGU * DM, WL_TOTAL = WL_D2 + (size_t)DM * DFF;
constexpr size_t WS_H = 624 * MiB;
constexpr size_t WS_CAT = 690 * MiB;
constexpr size_t WS_Y = 756 * MiB;
constexpr size_t WS_HID = 888 * MiB;
constexpr size_t WS_Z = WS_HID;
constexpr size_t WS_SLAB = 1070 * MiB;
constexpr size_t WS_END = 1116 * MiB;
constexpr int KS_D = 11, KS_O = 8;
static_assert(WS_W + 4 * WL_TOTAL * 2 <= WS_H && WS_H + (size_t)M * DM * 2 <= WS_CAT && WS_CAT + (size_t)M * DM * 2 <= WS_Y && WS_Y + (size_t)M * DM * 4 <= WS_HID && WS_HID + (size_t)M * DFF * 2 <= WS_SLAB && WS_SLAB + (size_t)KS_D * MS * DM * 4 <= WS_END, "ws map");
static_assert(WS_ROWSTAT + (size_t)M * 12 * 4 <= WS_W && WS_SGAS + 768 * 1024 <= WS_ROWSTAT, "ws map small");
constexpr int CW_TMO = 0, CW_BAR = 4096;
constexpr int RING_OFF = 0, RING_BYTES = 131072, LDSCTL_OFF = RING_BYTES, MISC_OFF = LDSCTL_OFF + 320, LDS_BYTES = 147456;
constexpr int HTB = pg8::HTB;

typedef float f32x2 __attribute__((ext_vector_type(2)));
typedef unsigned u32x2 __attribute__((ext_vector_type(2)));
__device__ __forceinline__ float bf2f(unsigned short b) { return __builtin_bit_cast(float, (unsigned)b << 16); }
__device__ __forceinline__ float bflo(unsigned u) { return __builtin_bit_cast(float, u << 16); }
__device__ __forceinline__ float bfhi(unsigned u) { return __builtin_bit_cast(float, u & 0xffff0000u); }
__device__ __forceinline__ float wave_sum(float v) {
#pragma unroll
    for (int o = 1; o < 64; o <<= 1) v += __shfl_xor(v, o);
    return v;
}

struct Args { const float* in[19]; float* out; unsigned char* ws; int ph_lo, ph_hi; };
struct Frame { LAS unsigned char* lds; volatile LAS unsigned* MISC; gu32* ctl; int vcu, G; };
struct Tid { int tid, lane, wave; };
__device__ __forceinline__ Tid get_tid() { Tid t; t.tid = pg8::opaque_tid(); t.lane = t.tid & 63; t.wave = __builtin_amdgcn_readfirstlane(t.tid >> 6); return t; }

__device__ __forceinline__ void cvt_item(const float* src, int N, int k0, int n0, bf16* dst, int K, int drow0, LAS unsigned short* scr, int lane) {
    f32x4 v[16];
    const float* s = src + (size_t)(k0 + (lane >> 4)) * N + n0 + 4 * (lane & 15);
#pragma unroll
    for (int i = 0; i < 16; ++i) v[i] = *(const f32x4*)(s + (size_t)(4 * i) * N);
#pragma unroll
    for (int i = 0; i < 16; ++i) { const int kl = 4 * i + (lane >> 4), nl = 4 * (lane & 15);
#pragma unroll
        for (int j = 0; j < 4; ++j) scr[(nl + j) * 72 + kl] = (unsigned short)f2bf(v[i][j]); }
    LDS_WAIT(); asm volatile("" ::: "memory");
#pragma unroll
    for (int j = 0; j < 8; ++j) { const int nl = (lane >> 3) + 8 * j, c = lane & 7;
        const v4u o = *(const LAS v4u*)(scr + nl * 72 + 8 * c);
        *(v4u*)(dst + (size_t)(drow0 + nl) * K + k0 + 8 * c) = o; }
    LDS_WAIT(); asm volatile("" ::: "memory");
}
__device__ __forceinline__ void convert_weights(const Frame& F, const Args& a) {
    const Tid t = get_tid();
    LAS unsigned short* scr = (LAS unsigned short*)(F.lds + RING_OFF + t.wave * 9216);
    const int gw = F.vcu * NWAVES + t.wave, NGW = F.G * NWAVES;
    constexpr int IPL = 19712;
    bf16* Wb = (bf16*)(a.ws + WS_W);
    for (int it = gw; it < IPL * DEPTH; it += NGW) {
        const int l = it / IPL; int r = it % IPL; bf16* wl = Wb + (size_t)l * WL_TOTAL;
        const float* src; int N, K; bf16* dst; int kind;
        if (r < 2816)       { src = a.in[5] + (size_t)(l * 2 + 0) * DM * DFF; N = DFF; K = DM; dst = wl + WL_GU1; kind = 1; }
        else if (r < 5632)  { r -= 2816;  src = a.in[6] + (size_t)(l * 2 + 0) * DM * DFF; N = DFF; K = DM; dst = wl + WL_GU1; kind = 2; }
        else if (r < 8448)  { r -= 5632;  src = a.in[7] + (size_t)(l * 2 + 0) * DFF * DM; N = DM; K = DFF; dst = wl + WL_D1; kind = 0; }
        else if (r < 10240) { r -= 8448;  src = a.in[8] + (size_t)l * DM * DIN; N = DIN; K = DM; dst = wl + WL_IN; kind = 3; }
        else if (r < 11264) { r -= 10240; src = a.in[18] + (size_t)l * DM * DM; N = DM; K = DM; dst = wl + WL_OUT; kind = 0; }
        else if (r < 14080) { r -= 11264; src = a.in[5] + (size_t)(l * 2 + 1) * DM * DFF; N = DFF; K = DM; dst = wl + WL_GU2; kind = 1; }
        else if (r < 16896) { r -= 14080; src = a.in[6] + (size_t)(l * 2 + 1) * DM * DFF; N = DFF; K = DM; dst = wl + WL_GU2; kind = 2; }
        else                { r -= 16896; src = a.in[7] + (size_t)(l * 2 + 1) * DFF * DM; N = DM; K = DFF; dst = wl + WL_D2; kind = 0; }
        const int nb = N >> 6, kb = r / nb, cb = r % nb, n0 = cb * 64; int drow0 = n0;
        if (kind == 1) drow0 = 256 * (n0 >> 7) + (n0 & 127);
        else if (kind == 2) drow0 = 256 * (n0 >> 7) + 128 + (n0 & 127);
        else if (kind == 3) { if (n0 >= 2816) drow0 = 2048 + 256 * ((n0 - 2816) >> 7) + 128 + ((n0 - 2816) & 127); else if (n0 >= 2048) drow0 = 2048 + 256 * ((n0 - 2048) >> 7) + ((n0 - 2048) & 127); }
        cvt_item(src, N, kb * 64, n0, dst, K, drow0, scr, t.lane);
    }
}
__device__ __forceinline__ void convert_small(const Frame& F, const Args& a) {
    const Tid t = get_tid();
    const int gt = F.vcu * (NWAVES * 64) + t.tid, NGT = F.G * NWAVES * 64;
    bf16* pwt = (bf16*)(a.ws + WS_PWT); bf16* sga = (bf16*)(a.ws + WS_SGA); bf16* sgas = (bf16*)(a.ws + WS_SGAS);
    for (int e = gt; e < DEPTH * 4 * 16384; e += NGT) { const int c = e & 127, d = (e >> 7) & 127, lg = e >> 14; pwt[e] = (bf16)f2bf(a.in[9][(size_t)lg * 16384 + c * 128 + d]); }
    for (int e = gt; e < DEPTH * 6 * 16384; e += NGT) { const int k = e & 127, q = (e >> 7) & 127, lh = e >> 14;
        sga[e] = (bf16)(k <= q ? f2bf(a.in[12][e]) : 0u);
        const int bq = q >> 5, qq = q & 31, bk = k >> 5, kk = k & 31;
        sgas[e] = (bf16)((bq == bk && kk <= qq) ? f2bf(a.in[12][(size_t)lh * 16384 + qq * 128 + kk]) : 0u); }
}

struct NRow { f32x4 x[8]; u32x2 y[8]; };
template <int MODE> __device__ __forceinline__ void nrow_load(NRow& r, const Args& a, int m, int lane) {
    if (MODE == 0) { const float* src = m < SEQ ? a.in[0] + (size_t)m * DM : a.in[1] + (size_t)(m - SEQ) * DM;
#pragma unroll
        for (int j = 0; j < 8; ++j) r.x[j] = *((const f32x4*)src + lane + 64 * j);
    } else { const float* X = a.out + O_Y + (size_t)m * DM; const bf16* Y = (const bf16*)(a.ws + WS_Y) + (size_t)m * DM;
#pragma unroll
        for (int j = 0; j < 8; ++j) { r.x[j] = *((const f32x4*)X + lane + 64 * j); r.y[j] = *((const u32x2*)Y + lane + 64 * j); } }
}
template <int MODE> __device__ __forceinline__ void nrow_finish(f32x4 (&xv)[8], const Args& a, int m, int lane, const f32x4 (&gq)[8]) {
    float* X = a.out + O_Y + (size_t)m * DM; bf16* H = (bf16*)(a.ws + WS_H) + (size_t)m * DM;
#pragma unroll
    for (int j = 0; j < 8; ++j) *((f32x4*)X + lane + 64 * j) = xv[j];
    if (MODE != 2) {
        float s2 = 0.f;
#pragma unroll
        for (int j = 0; j < 8; ++j) s2 += (xv[j][0] * xv[j][0] + xv[j][1] * xv[j][1]) + (xv[j][2] * xv[j][2] + xv[j][3] * xv[j][3]);
        const float r2 = 1.0f / sqrtf(wave_sum(s2) * (1.0f / DM) + EPS);
#pragma unroll
        for (int j = 0; j < 8; ++j) { const f32x4 o = (xv[j] * r2) * gq[j]; u32x2 w; w.x = pg8::cvt_pk_bf16(o[0], o[1]); w.y = pg8::cvt_pk_bf16(o[2], o[3]);
            *((u32x2*)H + lane + 64 * j) = w; }
    }
}
template <int MODE> __device__ __forceinline__ void norm_phase(const Frame& F, const Args& a, const float* gpost, float scale, const float* gpre, int nslab) {
    const Tid t = get_tid(); const int lane = t.lane;
    const int gw = F.vcu * NWAVES + t.wave, NGW = F.G * NWAVES;
    f32x4 gp[8], gq[8];
#pragma unroll
    for (int j = 0; j < 8; ++j) { gp[j] = (MODE != 0) ? *((const f32x4*)gpost + lane + 64 * j) : (f32x4){0.f, 0.f, 0.f, 0.f}; gq[j] = (MODE != 2) ? *((const f32x4*)gpre + lane + 64 * j) : (f32x4){0.f, 0.f, 0.f, 0.f}; }
    const int MEND = (MODE == 0) ? M : SEQ;
    int m = gw; NRow cur, nxt;
    if (m < MEND) nrow_load<MODE>(cur, a, m, lane);
    while (m < MEND) {
        const int mn = m + NGW;
        if (mn < MEND) nrow_load<MODE>(nxt, a, mn, lane);
        if (MODE != 0) { float s = 0.f; f32x4 yv[8];
#pragma unroll
            for (int j = 0; j < 8; ++j) { yv[j] = (f32x4){bflo(cur.y[j].x), bfhi(cur.y[j].x), bflo(cur.y[j].y), bfhi(cur.y[j].y)}; s += (yv[j][0] * yv[j][0] + yv[j][1] * yv[j][1]) + (yv[j][2] * yv[j][2] + yv[j][3] * yv[j][3]); }
            const float r = scale / sqrtf(wave_sum(s) * (1.0f / DM) + EPS);
#pragma unroll
            for (int j = 0; j < 8; ++j) cur.x[j] = cur.x[j] + (yv[j] * r) * gp[j]; }
        nrow_finish<MODE>(cur.x, a, m, lane, gq);
        cur = nxt; m = mn;
    }
    if (MODE != 0) {
        const float* SL = (const float*)(a.ws + WS_SLAB);
        for (int ms = gw; ms < MS; ms += NGW) { const int mr = SEQ + ms;
            f32x4 yv[8], xv[8];
#pragma unroll
            for (int j = 0; j < 8; ++j) { xv[j] = *((const f32x4*)(a.out + O_Y + (size_t)mr * DM) + lane + 64 * j); yv[j] = *((const f32x4*)(SL + (size_t)ms * DM) + lane + 64 * j); }
            for (int k = 1; k < nslab; ++k) {
#pragma unroll
                for (int j = 0; j < 8; ++j) yv[j] = yv[j] + *((const f32x4*)(SL + ((size_t)k * MS + ms) * DM) + lane + 64 * j); }
            float s = 0.f;
#pragma unroll
            for (int j = 0; j < 8; ++j) s += (yv[j][0] * yv[j][0] + yv[j][1] * yv[j][1]) + (yv[j][2] * yv[j][2] + yv[j][3] * yv[j][3]);
            const float r = scale / sqrtf(wave_sum(s) * (1.0f / DM) + EPS);
#pragma unroll
            for (int j = 0; j < 8; ++j) xv[j] = xv[j] + (yv[j] * r) * gp[j];
            nrow_finish<MODE>(xv, a, mr, lane, gq);
        }
    }
}

__device__ __forceinline__ void quad_mma(LAS unsigned char* la, LAS unsigned char* lb, int wr, int wc, int fr, int fq, f32x4 (&acc)[4][2]) {
    const int aoff = pg8::lds_byte(wr * 64 + fr, fq * 8), boff = pg8::lds_byte(wc * 32 + fr, fq * 8);
#pragma unroll
    for (int m = 0; m < 4; ++m)
#pragma unroll
        for (int n = 0; n < 2; ++n) acc[m][n] = (f32x4){0.f, 0.f, 0.f, 0.f};
#pragma unroll
    for (int kb = 0; kb < 2; ++kb) {
        bf16x8 At[4][2], Bf[2][2];
#pragma unroll
        for (int m = 0; m < 4; ++m)
#pragma unroll
            for (int k = 0; k < 2; ++k) At[m][k] = *(const LAS bf16x8*)(la + kb * HTB + aoff + m * 2048 + k * 1024);
#pragma unroll
        for (int n = 0; n < 2; ++n)
#pragma unroll
            for (int k = 0; k < 2; ++k) Bf[n][k] = *(const LAS bf16x8*)(lb + kb * HTB + boff + n * 2048 + k * 1024);
#pragma unroll
        for (int m = 0; m < 4; ++m)
#pragma unroll
            for (int n = 0; n < 2; ++n)
#pragma unroll
                for (int k = 0; k < 2; ++k) acc[m][n] = __builtin_amdgcn_mfma_f32_16x16x32_bf16(Bf[n][k], At[m][k], acc[m][n], 0, 0, 0);
    }
}
__device__ __forceinline__ void stage_image(const bf16* src, LAS unsigned char* img, int tid) {
#pragma unroll
    for (int kb = 0; kb < 2; ++kb)
#pragma unroll
        for (int i = 0; i < 2; ++i) { const int b = tid * 16 + i * 8192; int R, C; pg8::stage_rc(b, R, C);
            *(LAS v4u*)(img + kb * HTB + b) = *(const v4u*)(src + R * 128 + kb * 64 + C); }
}

__device__ __forceinline__ void pool_unit(const Frame& F, const Args& a, int l, int T, int g) {
    LAS unsigned short* PB = (LAS unsigned short*)(F.lds + 0);
    LAS unsigned char* LA = F.lds + 49152; LAS unsigned char* LB = F.lds + 81920;
    const bf16* Z = (const bf16*)(a.ws + WS_Z); bf16* CAT = (bf16*)(a.ws + WS_CAT);
    const Tid t = get_tid(); const int r0 = 128 * T; const bool sample = r0 >= SEQ; const int tid = t.tid;
    __syncthreads();
    stage_image((const bf16*)(a.ws + WS_PWT) + (size_t)(l * 4 + g) * 16384, LB, tid);
    for (int it = tid; it < 4 * 47 * 16; it += NWAVES * 64) {
        const int seg = it / 752, rem = it % 752, rr = rem >> 4, ch = rem & 15;
        v4u val = (v4u){0u, 0u, 0u, 0u};
        if (sample && rr < 15) { const int b = ((r0 - SEQ) >> 5) + seg; const float* s = a.in[2] + ((size_t)(l * DEC_B + b) * 15 + rr) * DPOOL + g * 128 + 8 * ch;
            const f32x4 p0 = *(const f32x4*)s, p1 = *(const f32x4*)(s + 4);
            val.x = pg8::cvt_pk_bf16(p0[0], p0[1]); val.y = pg8::cvt_pk_bf16(p0[2], p0[3]); val.z = pg8::cvt_pk_bf16(p1[0], p1[1]); val.w = pg8::cvt_pk_bf16(p1[2], p1[3]);
        } else { const int row = r0 + 32 * seg + rr - 15; if (row >= 0) val = *(const v4u*)(Z + (size_t)row * ZP + g * 128 + 8 * ch); }
        *(LAS v4u*)(PB + (seg * 47 + rr) * 128 + 8 * ch) = val;
    }
    __syncthreads();
    { const int c = tid & 127, seg = tid >> 7, w = 2 << g;
        for (int tau = 0; tau < 32; ++tau) {
            float s = 0.f; const LAS unsigned short* p = PB + (seg * 47 + 15 + tau) * 128 + c;
            for (int j = 0; j < w; ++j) s += bf2f(p[-j * 128]);
            const int pos1 = r0 + 32 * seg + tau + 1; const int cnt = (sample || pos1 > w) ? w : pos1;
            const float pooled = s / (float)cnt - bf2f(p[0]);
            *(LAS unsigned short*)(LA + (c >> 6) * HTB + pg8::lds_byte(32 * seg + tau, c & 63)) = (unsigned short)f2bf(pooled);
        } }
    __syncthreads();
    const int wr = t.wave >> 2, wc = t.wave & 3, fr = t.lane & 15, fq = t.lane >> 4;
    f32x4 acc[4][2]; quad_mma(LA, LB, wr, wc, fr, fq, acc);
    const float* sc = a.in[10] + l * DPOOL + g * 128;
#pragma unroll
    for (int m = 0; m < 4; ++m)
#pragma unroll
        for (int n = 0; n < 2; ++n) { const int row = r0 + 64 * wr + 16 * m + fr, col = 32 * wc + 16 * n + 4 * fq; const f32x4 s4 = *(const f32x4*)(sc + col), o = acc[m][n] * s4;
            u32x2 w2; w2.x = pg8::cvt_pk_bf16(o[0], o[1]); w2.y = pg8::cvt_pk_bf16(o[2], o[3]); *(u32x2*)(CAT + (size_t)row * DM + g * 128 + col) = w2; }
}

__device__ __forceinline__ void sgu_unit(const Frame& F, const Args& a, int l, int T, int h) {
    LAS unsigned char* LA = F.lds + 0; LAS unsigned char* LB = F.lds + 32768; LAS float* RS = (LAS float*)(F.lds + 65536);
    const bf16* Z = (const bf16*)(a.ws + WS_Z); bf16* CAT = (bf16*)(a.ws + WS_CAT); const float* rowstat = (const float*)(a.ws + WS_ROWSTAT);
    const Tid t = get_tid(); const int r0 = 128 * T; const bool sample = r0 >= SEQ; const int tid = t.tid;
    __syncthreads();
    if (tid < 128) { const f32x4* rs = (const f32x4*)(rowstat + (size_t)(r0 + tid) * 12); const f32x4 s0 = rs[0], s1 = rs[1], s2 = rs[2];
        const float s = ((s0[0] + s0[1]) + (s0[2] + s0[3])) + ((s1[0] + s1[1]) + (s1[2] + s1[3])) + ((s2[0] + s2[1]) + (s2[2] + s2[3]));
        RS[tid] = 1.0f / sqrtf(s * (1.0f / DSGU) + EPS); }
    stage_image((const bf16*)(a.ws + (sample ? WS_SGAS : WS_SGA)) + (size_t)(l * 6 + h) * 16384, LA, tid);
    __syncthreads();
#pragma unroll
    for (int i = 0; i < 4; ++i) { const int it = tid + 512 * i, k = it >> 4, ch = it & 15;
        const v4u gv = *(const v4u*)(Z + (size_t)(r0 + k) * ZP + 1280 + 128 * h + 8 * ch);
        const float r = RS[k]; const float* gp = a.in[11] + l * DSGU + 128 * h + 8 * ch; const f32x4 g0 = *(const f32x4*)gp, g1 = *(const f32x4*)(gp + 4);
        float v[8]; v[0] = bflo(gv.x) * r * g0[0]; v[1] = bfhi(gv.x) * r * g0[1]; v[2] = bflo(gv.y) * r * g0[2]; v[3] = bfhi(gv.y) * r * g0[3];
        v[4] = bflo(gv.z) * r * g1[0]; v[5] = bfhi(gv.z) * r * g1[1]; v[6] = bflo(gv.w) * r * g1[2]; v[7] = bfhi(gv.w) * r * g1[3];
#pragma unroll
        for (int j = 0; j < 8; ++j) *(LAS unsigned short*)(LB + (k >> 6) * HTB + pg8::lds_byte(8 * ch + j, k & 63)) = (unsigned short)f2bf(v[j]);
        if (sample) { const int b = ((r0 - SEQ) >> 5) + (k >> 5), tau = k & 31; float* o = a.out + O_V + ((size_t)(l * DEC_B + b) * DEC_T + tau) * DSGU + 128 * h + 8 * ch;
            *(f32x4*)o = (f32x4){v[0], v[1], v[2], v[3]}; *(f32x4*)(o + 4) = (f32x4){v[4], v[5], v[6], v[7]}; }
    }
    __syncthreads();
    const int wr = t.wave >> 2, wc = t.wave & 3, fr = t.lane & 15, fq = t.lane >> 4;
    f32x4 acc[4][2]; quad_mma(LA, LB, wr, wc, fr, fq, acc);
    const float* sb = a.in[13] + (l * 6 + h) * 128;
#pragma unroll
    for (int m = 0; m < 4; ++m) { const int rl = 64 * wr + 16 * m + fr; const float bias = sb[sample ? (rl & 31) : rl];
#pragma unroll
        for (int n = 0; n < 2; ++n) { const int col = 512 + 128 * h + 32 * wc + 16 * n + 4 * fq; const u32x2 uu = *(const u32x2*)(Z + (size_t)(r0 + rl) * ZP + col);
            const f32x4 o = (f32x4){bflo(uu.x), bfhi(uu.x), bflo(uu.y), bfhi(uu.y)} * (acc[m][n] + bias);
            u32x2 w2; w2.x = pg8::cvt_pk_bf16(o[0], o[1]); w2.y = pg8::cvt_pk_bf16(o[2], o[3]); *(u32x2*)(CAT + (size_t)(r0 + rl) * DM + col) = w2; } }
}

__device__ __forceinline__ void conv_unit(const Frame& F, const Args& a, int l, int U) {
    LAS float* RED = (LAS float*)(F.lds + 0);
    const bf16* Z = (const bf16*)(a.ws + WS_Z); bf16* CAT = (bf16*)(a.ws + WS_CAT);
    const Tid t = get_tid(); const int r0 = 32 * U; const bool sample = r0 >= SEQ; const int tid = t.tid; const bool active = tid < 384; const int ch = active ? 2 * tid : 0;
    __syncthreads();
    unsigned win[62]; f32x2 wv[31];
#pragma unroll
    for (int i = 0; i < 62; ++i) {
        unsigned v = 0u;
        if (sample && i < 30) { const int b = (r0 - SEQ) >> 5; const f32x2 hv = *(const f32x2*)(a.in[3] + ((size_t)(l * DEC_B + b) * 30 + i) * DCONV + ch); v = pg8::cvt_pk_bf16(hv[0], hv[1]); }
        else { const int row = r0 - 30 + i; if (row >= 0) v = *(const unsigned*)(Z + (size_t)row * ZP + 2048 + ch); }
        win[i] = v;
    }
#pragma unroll
    for (int j = 0; j < 31; ++j) wv[j] = *(const f32x2*)(a.in[14] + ((size_t)l * CONVK + j) * DCONV + ch);
    const f32x2 cb = *(const f32x2*)(a.in[15] + l * DCONV + ch), lg = *(const f32x2*)(a.in[16] + l * DCONV + ch), lb = *(const f32x2*)(a.in[17] + l * DCONV + ch);
#pragma unroll
    for (int blk = 0; blk < 4; ++blk) {
        f32x2 y[8];
#pragma unroll
        for (int o = 0; o < 8; ++o) y[o] = cb;
#pragma unroll
        for (int i = 0; i < 38; ++i) { const unsigned u = win[8 * blk + i]; const f32x2 x = (f32x2){bflo(u), bfhi(u)};
#pragma unroll
            for (int o = 0; o < 8; ++o) { const int j = i - o; if (j >= 0 && j < 31) y[o] = y[o] + x * wv[j]; } }
        float st[16];
#pragma unroll
        for (int o = 0; o < 8; ++o) { const float s1 = active ? y[o][0] + y[o][1] : 0.f, s2 = active ? y[o][0] * y[o][0] + y[o][1] * y[o][1] : 0.f; st[2 * o] = wave_sum(s1); st[2 * o + 1] = wave_sum(s2); }
        if (t.lane == 0 && t.wave < 6) {
#pragma unroll
            for (int q = 0; q < 16; ++q) RED[((blk & 1) * 6 + t.wave) * 16 + q] = st[q]; }
        __syncthreads();
#pragma unroll
        for (int o = 0; o < 8; ++o) { float s1 = 0.f, s2 = 0.f;
#pragma unroll
            for (int w = 0; w < 6; ++w) { s1 += RED[((blk & 1) * 6 + w) * 16 + 2 * o]; s2 += RED[((blk & 1) * 6 + w) * 16 + 2 * o + 1]; }
            const float mean = s1 * (1.0f / DCONV), var = s2 * (1.0f / DCONV) - mean * mean, rstd = 1.0f / sqrtf(fmaxf(var, 0.f) + EPS);
            const float z0 = (y[o][0] - mean) * rstd * lg[0] + lb[0], z1 = (y[o][1] - mean) * rstd * lg[1] + lb[1];
            if (active) *(unsigned*)(CAT + (size_t)(r0 + 8 * blk + o) * DM + 1280 + ch) = pg8::cvt_pk_bf16(z0 * pg8::sigmoid_f(z0), z1 * pg8::sigmoid_f(z1)); }
    }
}
__device__ __forceinline__ void state_copy(const Frame& F, const Args& a, int l) {
    const bf16* Z = (const bf16*)(a.ws + WS_Z); const Tid t = get_tid();
    const int gt = F.vcu * (NWAVES * 64) + t.tid, NGT = F.G * NWAVES * 64;
    for (int e = gt; e < 522240; e += NGT) {
        size_t zi, oi;
        if (e < 7680) { const int r = e >> 9, c = e & 511; zi = (size_t)(SEQ - 15 + r) * ZP + c; oi = O_POOLP + (size_t)l * 7680 + e; }
        else if (e < 30720) { const int e2 = e - 7680, r = e2 / 768, c = e2 % 768; zi = (size_t)(SEQ - 30 + r) * ZP + 2048 + c; oi = O_CONVP + (size_t)l * 23040 + e2; }
        else if (e < 153600) { const int e2 = e - 30720, b = e2 / 7680, rem = e2 % 7680, r = rem >> 9, c = rem & 511; zi = (size_t)(SEQ + b * 32 + 17 + r) * ZP + c; oi = O_POOLS + (size_t)(l * DEC_B + b) * 7680 + rem; }
        else { const int e2 = e - 153600, b = e2 / 23040, rem = e2 % 23040, r = rem / 768, c = rem % 768; zi = (size_t)(SEQ + b * 32 + 2 + r) * ZP + 2048 + c; oi = O_CONVS + (size_t)(l * DEC_B + b) * 23040 + rem; }
        a.out[oi] = bf2f(Z[zi]);
    }
}
__device__ __forceinline__ void mixer_phase(const Frame& F, const Args& a, int l) {
    constexpr int NT = M / 128, NSGU = NT * 6, NCONV = M / 32, NPOOL = NT * 4;
    for (int u = F.vcu; u < NSGU; u += F.G) sgu_unit(F, a, l, u / 6, u % 6);
    for (int u = (F.vcu + F.G - (NSGU % 256)) % F.G; u < NCONV; u += F.G) conv_unit(F, a, l, u);
    for (int u = (F.vcu + F.G - ((NSGU + NCONV) % 256)) % F.G; u < NPOOL; u += F.G) pool_unit(F, a, l, u >> 2, u & 3);
    state_copy(F, a, l);
}

__global__ void __launch_bounds__(NWAVES * 64, 2) fwd_kernel(Args args) {
    extern __shared__ __attribute__((aligned(16))) unsigned char lds[];
    Frame F;
    F.lds = (LAS unsigned char*)lds; F.MISC = (volatile LAS unsigned*)(F.lds + MISC_OFF);
    F.G = gridDim.x; { const int bx = blockIdx.x; F.vcu = (F.G % 8 == 0) ? (bx % 8) * (F.G / 8) + bx / 8 : bx; }
    F.ctl = (gu32*)(args.ws + WS_CTL);
    for (int u = threadIdx.x; u < (LDS_BYTES - LDSCTL_OFF) / 4; u += NWAVES * 64) ((LAS unsigned*)(F.lds + LDSCTL_OFF))[u] = 0u;
    __syncthreads();
    XcdBarrier bar; bar.bar = (unsigned*)(F.ctl + CW_BAR); bar.x = 0; bar.st = nullptr;
    if (!MK_MULTI) bar = xcd_barrier_post((unsigned*)(F.ctl + CW_BAR), F.MISC + 8);
    const int lo = args.ph_lo, hi = args.ph_hi;
#define IN(k) (lo <= (k) && (k) < hi)
#define SEAM(k) do { if (IN(k) && IN((k) + 1)) xcd_barrier(bar); } while (0)
    const float* ng = args.in[4];
    bf16* Wb = (bf16*)(args.ws + WS_W); bf16* H = (bf16*)(args.ws + WS_H); bf16* CAT = (bf16*)(args.ws + WS_CAT); bf16* HID = (bf16*)(args.ws + WS_HID); bf16* Z = (bf16*)(args.ws + WS_Z);
    bf16* Yb = (bf16*)(args.ws + WS_Y); float* SLAB = (float*)(args.ws + WS_SLAB); float* rowstat = (float*)(args.ws + WS_ROWSTAT);

    if (IN(0)) { for (int rep = 0; rep < PR_CVT; ++rep) convert_weights(F, args); convert_small(F, args); norm_phase<0>(F, args, nullptr, 0.f, ng, 0); }
    SEAM(0);
    for (int l0 = 0; l0 < DEPTH; ++l0) {
        for (int s0 = 0; s0 < 3; ++s0) {
            int l = l0, s = s0; asm volatile("" : "+s"(l), "+s"(s));
            const bf16* wl = Wb + (size_t)l * WL_TOTAL; const int pb = 1 + 10 * l;
            if (s != 1) {
                const int p0 = pb + (s ? 7 : 0);
                if (IN(p0)) for (int rep = 0; rep < PR_GU; ++rep) { pg8::Gemm g{H, wl + (s ? WL_GU2 : WL_GU1), M, NGU, DM, DM}; pg8::StaticOrder S; S.init(M, NGU, F.G, (int)blockIdx.x); pg8::EpiSwiGLU E{HID, DFF};
                    pg8::gemm_phase<pg8::EpiSwiGLU, pg8::StaticOrder, true, true>(F.lds + RING_OFF, g, S, E); }
                SEAM(p0);
                if (IN(p0 + 1)) for (int rep = 0; rep < PR_D; ++rep) {
                    { pg8::Gemm g{HID, wl + (s ? WL_D2 : WL_D1), SEQ, DM, DFF, DFF}; pg8::StaticOrder S; S.init(SEQ, DM, F.G, (int)blockIdx.x); pg8::EpiBf16Y E{Yb, DM};
                      pg8::gemm_phase<pg8::EpiBf16Y, pg8::StaticOrder, true, true>(F.lds + RING_OFF, g, S, E); }
                    { pg8::Gemm g{HID, wl + (s ? WL_D2 : WL_D1), M, DM, DFF / KS_D, DFF}; pg8::SplitKOrder S{KS_D * 16, F.G, F.vcu, DM / 256, SEQ / 256, (DFF / KS_D) * 2}; pg8::EpiF32Y E{SLAB, DM, SEQ, (size_t)MS * DM};
                      pg8::gemm_phase<pg8::EpiF32Y, pg8::SplitKOrder, true, true>(F.lds + RING_OFF, g, S, E); } }
                SEAM(p0 + 1);
                if (IN(p0 + 2)) { const float* gpost = ng + (size_t)(l * 6 + (s ? 5 : 1)) * DM;
                    if (s == 0) norm_phase<1>(F, args, gpost, 0.5f, ng + (size_t)(l * 6 + 2) * DM, KS_D);
                    else if (l + 1 < DEPTH) norm_phase<1>(F, args, gpost, 0.5f, ng + (size_t)((l + 1) * 6 + 0) * DM, KS_D);
                    else norm_phase<2>(F, args, gpost, 0.5f, nullptr, KS_D); }
                SEAM(p0 + 2);
            } else {
                const int p0 = pb + 3;
                if (IN(p0)) for (int rep = 0; rep < PR_WIN; ++rep) { pg8::Gemm g{H, wl + WL_IN, M, DIN, DM, DM}; pg8::StaticOrder S; S.init(M, DIN, F.G, (int)blockIdx.x); pg8::EpiWin E{Z, ZP, rowstat};
                    pg8::gemm_phase<pg8::EpiWin, pg8::StaticOrder, true, true>(F.lds + RING_OFF, g, S, E); }
                SEAM(p0);
                if (IN(p0 + 1)) for (int rep = 0; rep < PR_MIX; ++rep) mixer_phase(F, args, l);
                SEAM(p0 + 1);
                if (IN(p0 + 2)) {
                    { pg8::Gemm g{CAT, wl + WL_OUT, SEQ, DM, DM, DM}; pg8::StaticOrder S; S.init(SEQ, DM, F.G, (int)blockIdx.x); pg8::EpiBf16Y E{Yb, DM};
                      pg8::gemm_phase<pg8::EpiBf16Y, pg8::StaticOrder, true, true>(F.lds + RING_OFF, g, S, E); }
                    { pg8::Gemm g{CAT, wl + WL_OUT, M, DM, DM / KS_O, DM}; pg8::SplitKOrder S{KS_O * 16, F.G, F.vcu, DM / 256, SEQ / 256, (DM / KS_O) * 2}; pg8::EpiF32Y E{SLAB, DM, SEQ, (size_t)MS * DM};
                      pg8::gemm_phase<pg8::EpiF32Y, pg8::SplitKOrder, true, true>(F.lds + RING_OFF, g, S, E); } }
                SEAM(p0 + 2);
                if (IN(p0 + 3)) norm_phase<1>(F, args, ng + (size_t)(l * 6 + 3) * DM, 1.0f, ng + (size_t)(l * 6 + 4) * DM, KS_O);
                SEAM(p0 + 3);
            }
        }
    }
#undef IN
#undef SEAM
}

extern "C" void kernel_launch(void* const* d_in, const int* in_sizes, int n_in, void* d_out, int out_size, void* d_ws, size_t ws_size, hipStream_t stream) {
    static int grid = 0;
    if (grid == 0) {
        if (n_in != 19 || (size_t)out_size != O_END || ws_size < WS_END) { fprintf(stderr, "kernel_launch: unexpected sizes: n_in %d out %d ws %zu (need %zu)\n", n_in, out_size, ws_size, (size_t)WS_END); grid = -1; return; }
        int dev = 0, cus = 0, per_cu = 0;
        if (hipGetDevice(&dev) != hipSuccess || hipDeviceGetAttribute(&cus, hipDeviceAttributeMultiprocessorCount, dev) != hipSuccess) { grid = -1; return; }
        if (hipFuncSetAttribute((const void*)fwd_kernel, hipFuncAttributeMaxDynamicSharedMemorySize, LDS_BYTES) != hipSuccess) { fprintf(stderr, "kernel_launch: hipFuncSetAttribute failed\n"); grid = -1; return; }
        if (hipOccupancyMaxActiveBlocksPerMultiprocessor(&per_cu, (const void*)fwd_kernel, NWAVES * 64, LDS_BYTES) != hipSuccess || per_cu < 1) fprintf(stderr, "kernel_launch: occupancy query says %d\n", per_cu);
        (void)hipGetLastError();
        grid = cus;
    }
    if (grid < 0) return;
    (void)hipMemsetAsync((char*)d_ws + WS_CTL, 0, CTL_ZERO_BYTES, stream);
    Args a{};
    for (int i = 0; i < 19; ++i) a.in[i] = (const float*)d_in[i];
    a.out = (float*)d_out; a.ws = (unsigned char*)d_ws;
#if MK_MULTI
    for (int p = 0; p < NPHASE; ++p) { a.ph_lo = p; a.ph_hi = p + 1; hipLaunchKernelGGL(fwd_kernel, dim3(grid), dim3(NWAVES * 64), LDS_BYTES, stream, a); }
#else
    a.ph_lo = 0; a.ph_hi = NPHASE; hipLaunchKernelGGL(fwd_kernel, dim3(grid), dim3(NWAVES * 64), LDS_BYTES, stream, a);
#endif
}
```

```cpp
#include <hip/hip_runtime.h>
#include <cstdio>
#include <cstdint>
#define MK_MULTI 0
namespace pg8 {
#define PG8_LAS __attribute__((address_space(3)))
typedef unsigned short bf16_t;
typedef short bf16x8 __attribute__((ext_vector_type(8)));
typedef float f32x4 __attribute__((ext_vector_type(4)));
typedef unsigned u32x4 __attribute__((ext_vector_type(4)));
constexpr int BM = 256, BK = 64, HALF = 128, HTB = HALF * BK * 2  , STAGE_BYTES = 8 * HTB, NXCD = 8, WGM = 8;

__host__ __device__ __forceinline__ int lds_byte(int r, int c) { const int st = (r >> 4) * 2 + (c >> 5), rr = r & 15, cc = c & 31, ob = rr * 64 + cc * 2; return st * 1024 + (ob ^ (((ob >> 9) & 1) << 5)); }
__host__ __device__ __forceinline__ void stage_rc(int b, int& R, int& C) { const int st = b / 1024, sb = b % 1024, swz = sb ^ (((sb >> 9) & 1) << 5); R = (st >> 1) * 16 + swz / 64; C = (st & 1) * 32 + (swz % 64) / 2; }
__host__ __device__ __forceinline__ int perm32(int rho) { const int n = rho >> 4, i = rho & 15; return 8 * (i >> 2) + 4 * n + (i & 3); }

__device__ __forceinline__ int opaque_tid() { int t = threadIdx.x; asm volatile("" : "+v"(t)); return t; }
struct Unit { int pm, pn, koffA, koffB, aux; };
struct Gemm { const bf16_t* A; const bf16_t* Bt; int M, N, K, ldA, ldB; bool tiledA, tiledB; };

struct StaticOrder {
    int nM, nN, nwg, G, c;
    __host__ __device__ void init(int M, int N, int G_, int c_) { nM = M / BM; nN = N / BM; nwg = nM * nN; G = G_; c = c_; }
    __host__ __device__ bool next(int i, Unit& u) const {
        const long L = (long)i * G + c; if (L >= nwg) return false;
        int wgid = (int)L; { const int q = nwg / NXCD, r = nwg % NXCD, xcd = wgid % NXCD, off = wgid / NXCD; wgid = (xcd < r ? xcd * (q + 1) : r * (q + 1) + (xcd - r) * q) + off; }
        const int nig = WGM * nN, gid = wgid / nig, fm = gid * WGM, gsz = (nM - fm) < WGM ? (nM - fm) : WGM;
        u.pm = fm + ((wgid % nig) % gsz); u.pn = (wgid % nig) / gsz; u.koffA = 0; u.koffB = 0; u.aux = 0; return true;
    }
    __device__ __forceinline__ void a_ready(const Unit&) const {}
    __device__ __forceinline__ void done(const Unit&) const {}
};
__device__ __forceinline__ unsigned cvt_pk_bf16(float lo, float hi) { unsigned r; asm volatile("v_cvt_pk_bf16_f32 %0, %1, %2" : "=v"(r) : "v"(lo), "v"(hi)); return r; }
typedef float f32x2 __attribute__((ext_vector_type(2)));
__device__ __forceinline__ f32x2 gelu_pk(f32x2 v) {
    const f32x2 av = __builtin_elementwise_abs(v), d = av * 0.2316418882f + 1.0f;
    f32x2 t; t.x = __builtin_amdgcn_rcpf(d.x); t.y = __builtin_amdgcn_rcpf(d.y);
    f32x2 q = t * 0.5307027145f + (-0.7265760135f); q = q * t + 0.7107068705f; q = q * t + (-0.142248368f); q = q * t + 0.127414796f; q = q * t;
    const f32x2 s = (v * v) * (-0.72134752044f);
    f32x2 e; e.x = __builtin_amdgcn_exp2f(s.x); e.y = __builtin_amdgcn_exp2f(s.y);
    const f32x2 m = v * (q * e), r = v - m;
    f32x2 o; o.x = v.x < 0.f ? m.x : r.x; o.y = v.y < 0.f ? m.y : r.y; return o;
}
__device__ __forceinline__ float sigmoid_f(float x) { return __builtin_amdgcn_rcpf(1.0f + __builtin_amdgcn_exp2f(x * -1.44269504089f)); }
struct EpiF32Y {
    static constexpr bool PERM = false, AFTER_DRAIN = false;
    float* C; int ldc; int row_sub; size_t aux_stride;
    __device__ __forceinline__ void operator()(const f32x4 (&acc)[2][2][4][2], const Unit& u, int wr, int wc, int fr, int fq) const {
        const int row0 = u.pm * BM - row_sub + wr * 64 + fr, col0 = u.pn * BM + wc * 32 + 4 * fq; float* base = C + (size_t)u.aux * aux_stride;
#pragma unroll
        for (int ai = 0; ai < 2; ++ai)
#pragma unroll
            for (int m = 0; m < 4; ++m) { float* rowp = base + (size_t)(row0 + ai * HALF + m * 16) * ldc + col0;
#pragma unroll
                for (int bj = 0; bj < 2; ++bj)
#pragma unroll
                    for (int n = 0; n < 2; ++n) *(f32x4*)(rowp + bj * HALF + n * 16) = acc[ai][bj][m][n]; }
    }
};
struct EpiBf16Y {
    static constexpr bool PERM = true, AFTER_DRAIN = false;
    bf16_t* O; int ldc;
    __device__ __forceinline__ void operator()(const f32x4 (&acc)[2][2][4][2], const Unit& u, int wr, int wc, int fr, int fq) const {
        const int row0 = u.pm * BM + wr * 64 + fr, col0 = u.pn * BM + wc * 32 + 8 * fq;
#pragma unroll
        for (int ai = 0; ai < 2; ++ai)
#pragma unroll
            for (int m = 0; m < 4; ++m) { bf16_t* rowp = O + (size_t)(row0 + ai * HALF + m * 16) * ldc + col0;
#pragma unroll
                for (int bj = 0; bj < 2; ++bj) { const f32x4 v0 = acc[ai][bj][m][0], v1 = acc[ai][bj][m][1];
                    u32x4 w; w.x = cvt_pk_bf16(v0[0], v0[1]); w.y = cvt_pk_bf16(v0[2], v0[3]); w.z = cvt_pk_bf16(v1[0], v1[1]); w.w = cvt_pk_bf16(v1[2], v1[3]);
                    *(u32x4*)(rowp + bj * HALF) = w; } }
    }
};
struct PanelOrder {
    int v;
    __device__ __forceinline__ bool next(int i, Unit& u) const { if (i >= 2) return false; u.pm = 8 * (v >> 5) + 4 * i + ((v & 31) >> 3); u.pn = v & 7; u.koffA = 0; u.koffB = 0; u.aux = 0; return true; }
    __device__ __forceinline__ void a_ready(const Unit&) const {}
    __device__ __forceinline__ void done(const Unit&) const {}
};
struct SplitKOrder {
    int nsub, G, c, npn, pm0, kbytesA, kbytesB;
    __device__ __forceinline__ bool next(int i, Unit& u) const { const int j = i * G + c; if (j >= nsub) return false; const int per = 2 * npn, ks = j / per, r = j % per;
        u.pm = pm0 + r / npn; u.pn = r % npn; u.koffA = ks * kbytesA; u.koffB = ks * kbytesB; u.aux = ks; return true; }
    __device__ __forceinline__ void a_ready(const Unit&) const {}
    __device__ __forceinline__ void done(const Unit&) const {}
};
struct RangeOrder { StaticOrder S; int i0, i1;
    __device__ __forceinline__ bool next(int i, Unit& u) const { if (i + i0 >= i1) return false; return S.next(i + i0, u); }
    __device__ __forceinline__ void a_ready(const Unit&) const {}
    __device__ __forceinline__ void done(const Unit&) const {} };
struct DegenOrder { int nr;
    __device__ __forceinline__ bool next(int i, Unit& u) const { if (i >= nr) return false; u.pm = 0; u.pn = 0; u.koffA = 0; u.koffB = 0; u.aux = 0; return true; }
    __device__ __forceinline__ void a_ready(const Unit&) const {}
    __device__ __forceinline__ void done(const Unit&) const {} };
struct EpiSwiGLU {
    static constexpr bool PERM = true, AFTER_DRAIN = false;
    bf16_t* O; int ldc;
    __device__ __forceinline__ void operator()(const f32x4 (&acc)[2][2][4][2], const Unit& u, int wr, int wc, int fr, int fq) const {
        const int row0 = u.pm * BM + wr * 64 + fr, col0 = u.pn * HALF + wc * 32 + 8 * fq;
#pragma unroll
        for (int ai = 0; ai < 2; ++ai)
#pragma unroll
            for (int m = 0; m < 4; ++m) { bf16_t* rowp = O + (size_t)(row0 + ai * HALF + m * 16) * ldc + col0;
                float h[8];
#pragma unroll
                for (int n = 0; n < 2; ++n)
#pragma unroll
                    for (int j = 0; j < 4; ++j) { const float g = acc[ai][0][m][n][j], up = acc[ai][1][m][n][j]; h[4 * n + j] = g * sigmoid_f(g) * up; }
                u32x4 w; w.x = cvt_pk_bf16(h[0], h[1]); w.y = cvt_pk_bf16(h[2], h[3]); w.z = cvt_pk_bf16(h[4], h[5]); w.w = cvt_pk_bf16(h[6], h[7]);
                *(u32x4*)rowp = w; }
    }
};
struct EpiWin {
    static constexpr bool PERM = true, AFTER_DRAIN = false;
    bf16_t* Z; int ldc; float* rowstat;
    __device__ __forceinline__ void operator()(const f32x4 (&acc)[2][2][4][2], const Unit& u, int wr, int wc, int fr, int fq) const {
        const int row0 = u.pm * BM + wr * 64 + fr; const int pn = u.pn;
        if (pn < 8) {
            const int col0 = pn * BM + wc * 32 + 8 * fq; const bool act = pn >= 2, stat = pn >= 5;
#pragma unroll
            for (int ai = 0; ai < 2; ++ai)
#pragma unroll
                for (int m = 0; m < 4; ++m) { const int row = row0 + ai * HALF + m * 16; bf16_t* rowp = Z + (size_t)row * ldc + col0; float ss = 0.f;
#pragma unroll
                    for (int bj = 0; bj < 2; ++bj) { f32x4 v0 = acc[ai][bj][m][0], v1 = acc[ai][bj][m][1];
                        if (act) { f32x2 a = gelu_pk((f32x2){v0[0], v0[1]}), b = gelu_pk((f32x2){v0[2], v0[3]}), c = gelu_pk((f32x2){v1[0], v1[1]}), d = gelu_pk((f32x2){v1[2], v1[3]});
                            v0 = (f32x4){a.x, a.y, b.x, b.y}; v1 = (f32x4){c.x, c.y, d.x, d.y}; }
                        ss += (v0[0] * v0[0] + v0[1] * v0[1]) + (v0[2] * v0[2] + v0[3] * v0[3]) + (v1[0] * v1[0] + v1[1] * v1[1]) + (v1[2] * v1[2] + v1[3] * v1[3]);
                        u32x4 w; w.x = cvt_pk_bf16(v0[0], v0[1]); w.y = cvt_pk_bf16(v0[2], v0[3]); w.z = cvt_pk_bf16(v1[0], v1[1]); w.w = cvt_pk_bf16(v1[2], v1[3]);
                        *(u32x4*)(rowp + bj * HALF) = w; }
                    if (stat) { ss += __shfl_xor(ss, 16); ss += __shfl_xor(ss, 32); if (fq == 0) rowstat[(size_t)row * 12 + (pn - 5) * 4 + wc] = ss; } }
        } else {
            const int col0 = 2048 + (pn - 8) * HALF + wc * 32 + 8 * fq;
#pragma unroll
            for (int ai = 0; ai < 2; ++ai)
#pragma unroll
                for (int m = 0; m < 4; ++m) { bf16_t* rowp = Z + (size_t)(row0 + ai * HALF + m * 16) * ldc + col0;
                    float h[8];
#pragma unroll
                    for (int n = 0; n < 2; ++n)
#pragma unroll
                        for (int j = 0; j < 4; ++j) h[4 * n + j] = acc[ai][0][m][n][j] * sigmoid_f(acc[ai][1][m][n][j]);
                    u32x4 w; w.x = cvt_pk_bf16(h[0], h[1]); w.y = cvt_pk_bf16(h[2], h[3]); w.z = cvt_pk_bf16(h[4], h[5]); w.w = cvt_pk_bf16(h[6], h[7]);
                    *(u32x4*)rowp = w; }
        }
    }
};
template <class Epi, class Sched, bool ALIGN_EPI = false, bool SP2 = false>
__device__ __forceinline__ void gemm_phase(PG8_LAS unsigned char* lds, const Gemm g, const Sched& S, const Epi& E) {
    const int tid = opaque_tid(), wid = __builtin_amdgcn_readfirstlane(tid >> 6), lane = tid & 63, wr = wid >> 2, wc = wid & 3, fr = lane & 15, fq = lane >> 4;
    const int K = g.K, LDA = g.ldA, LDB = g.ldB, nt = K / BK;
    unsigned voffA[2], voffB[2];
#pragma unroll
    for (int i = 0; i < 2; ++i) { int R, C; stage_rc(tid * 16 + i * 8192, R, C); const int Rb = Epi::PERM ? ((R & ~31) + perm32(R & 31)) : R;
        voffA[i] = (unsigned)(R * (g.tiledA ? 64 : LDA) + C) * 2u; voffB[i] = (unsigned)(Rb * (g.tiledB ? 64 : LDB) + C) * 2u; }
    const size_t kstepA = g.tiledA ? (size_t)32768 : (size_t)(BK * 2), kstepB = g.tiledB ? (size_t)32768 : (size_t)(BK * 2);
    const size_t hstepA = g.tiledA ? (size_t)16384 : (size_t)HALF * LDA * 2, hstepB = g.tiledB ? (size_t)16384 : (size_t)HALF * LDB * 2;
    const size_t tstepA = (size_t)BM * LDA * 2, tstepB = (size_t)BM * LDB * 2;
    const unsigned ldsw = (unsigned)wid * 1024u;
    const int aoff = lds_byte(wr * 64 + fr, fq * 8), boff = lds_byte(wc * 32 + fr, fq * 8);
#define PG8_SA(b, h) (((b) * 2 + (h)) * HTB)
#define PG8_SB(b, h) ((4 + (b) * 2 + (h)) * HTB)
#define PG8_STAGE(bufoff, gbase, voff) do { _Pragma("unroll") for (int _i = 0; _i < 2; ++_i) \
        __builtin_amdgcn_global_load_lds((const unsigned*)((const char*)(gbase) + (voff)[_i]), (PG8_LAS unsigned*)(lds + (bufoff) + ldsw + _i * 8192), 16, 0, 0); } while (0)
#define PG8_LDA(dst, b, h) do { _Pragma("unroll") for (int m = 0; m < 4; ++m) _Pragma("unroll") for (int k = 0; k < 2; ++k) dst[m][k] = *(const PG8_LAS bf16x8*)(lds + PG8_SA(b, h) + aoff + m * 2048 + k * 1024); } while (0)
#define PG8_LDB(dst, b, h) do { _Pragma("unroll") for (int n = 0; n < 2; ++n) _Pragma("unroll") for (int k = 0; k < 2; ++k) dst[n][k] = *(const PG8_LAS bf16x8*)(lds + PG8_SB(b, h) + boff + n * 2048 + k * 1024); } while (0)
#define PG8_MMA(ai, bj, At, Bt) do { __builtin_amdgcn_s_setprio(1); _Pragma("unroll") for (int m = 0; m < 4; ++m) _Pragma("unroll") for (int n = 0; n < 2; ++n) _Pragma("unroll") for (int k = 0; k < 2; ++k) \
        acc[ai][bj][m][n] = __builtin_amdgcn_mfma_f32_16x16x32_bf16(Bt[n][k], At[m][k], acc[ai][bj][m][n], 0, 0, 0); __builtin_amdgcn_s_setprio(0); } while (0)
#define PG8_WAIT_V(n) asm volatile("s_waitcnt vmcnt(" #n ")" ::: "memory")
#define PG8_WAIT_L(n) asm volatile("s_waitcnt lgkmcnt(" #n ")" ::: "memory")
#define PG8_BAR __builtin_amdgcn_s_barrier()
#define PG8_SCHED __builtin_amdgcn_sched_barrier(0)
    Unit cur, nxt; int ui = 0;
    if (!S.next(0, cur)) return;
    f32x4 acc[2][2][4][2];
#pragma unroll
    for (int a = 0; a < 2; ++a)
#pragma unroll
        for (int b = 0; b < 2; ++b)
#pragma unroll
            for (int m = 0; m < 4; ++m)
#pragma unroll
                for (int n = 0; n < 2; ++n) acc[a][b][m][n] = (f32x4){0.f, 0.f, 0.f, 0.f};
    bf16x8 At[4][2], B0[2][2], B1[2][2];
    const char* cA = (const char*)g.A + (size_t)cur.pm * tstepA + cur.koffA; const char* cB = (const char*)g.Bt + (size_t)cur.pn * tstepB + cur.koffB;
    S.a_ready(cur);
    if constexpr (SP2) {
        PG8_STAGE(PG8_SB(0, 0), cB, voffB); PG8_STAGE(PG8_SB(0, 1), cB + hstepB, voffB); PG8_STAGE(PG8_SA(0, 0), cA, voffA); PG8_STAGE(PG8_SA(0, 1), cA + hstepA, voffA);
        if (wr == 1) PG8_BAR;
        PG8_WAIT_V(2); PG8_BAR;
        PG8_STAGE(PG8_SB(1, 0), cB + kstepB, voffB); PG8_STAGE(PG8_SA(1, 0), cA + kstepA, voffA); PG8_STAGE(PG8_SB(1, 1), cB + hstepB + kstepB, voffB);
        PG8_WAIT_V(6); PG8_BAR;
    } else {
        PG8_STAGE(PG8_SB(0, 0), cB, voffB); PG8_STAGE(PG8_SA(0, 0), cA, voffA); PG8_STAGE(PG8_SB(0, 1), cB + hstepB, voffB); PG8_STAGE(PG8_SA(0, 1), cA + hstepA, voffA);
        if (wr == 1) PG8_BAR;
        PG8_WAIT_V(4); PG8_BAR;
        PG8_STAGE(PG8_SB(1, 0), cB + kstepB, voffB); PG8_STAGE(PG8_SA(1, 0), cA + kstepA, voffA); PG8_STAGE(PG8_SB(1, 1), cB + hstepB + kstepB, voffB);
        PG8_WAIT_V(6); PG8_BAR;
    }
    for (;;) {
        const bool has_next = S.next(ui + 1, nxt);
        const char* nA = has_next ? (const char*)g.A + (size_t)nxt.pm * tstepA + nxt.koffA : cA; const char* nB = has_next ? (const char*)g.Bt + (size_t)nxt.pn * tstepB + nxt.koffB : cB;
        for (int t = 0; t < nt; t += 2) {
            const bool last = (t == nt - 2);
            const char* a1 = cA + (size_t)(t + 1) * kstepA;
            const char* a2 = last ? nA : cA + (size_t)(t + 2) * kstepA; const char* b2 = last ? nB : cB + (size_t)(t + 2) * kstepB;
            const char* a3 = a2 + kstepA; const char* b3 = b2 + kstepB;
            if (last && has_next) S.a_ready(nxt);
            if constexpr (SP2) {
            PG8_LDB(B0, 0, 0); PG8_LDB(B1, 0, 1); PG8_SCHED; PG8_LDA(At, 0, 0); PG8_STAGE(PG8_SA(1, 1), a1 + hstepA, voffA);
            PG8_WAIT_V(8); PG8_WAIT_L(0); PG8_BAR; PG8_MMA(0, 0, At, B0); PG8_MMA(0, 1, At, B1); PG8_BAR; PG8_SCHED;
            PG8_LDA(At, 0, 1); PG8_STAGE(PG8_SB(0, 0), b2, voffB); PG8_STAGE(PG8_SB(0, 1), b2 + hstepB, voffB); PG8_STAGE(PG8_SA(0, 0), a2, voffA);
            PG8_WAIT_V(8); PG8_WAIT_L(0); PG8_BAR; PG8_MMA(1, 0, At, B0); PG8_MMA(1, 1, At, B1); PG8_BAR; PG8_SCHED;
            PG8_LDB(B0, 1, 0); PG8_LDB(B1, 1, 1); PG8_SCHED; PG8_LDA(At, 1, 0); PG8_STAGE(PG8_SA(0, 1), a2 + hstepA, voffA);
            PG8_WAIT_V(8); PG8_WAIT_L(0); PG8_BAR; PG8_MMA(0, 0, At, B0); PG8_MMA(0, 1, At, B1); PG8_BAR; PG8_SCHED;
            PG8_LDA(At, 1, 1); PG8_STAGE(PG8_SB(1, 0), b3, voffB); PG8_STAGE(PG8_SB(1, 1), b3 + hstepB, voffB); PG8_STAGE(PG8_SA(1, 0), a3, voffA);
            PG8_WAIT_V(8); PG8_WAIT_L(0); PG8_BAR; PG8_MMA(1, 0, At, B0); PG8_MMA(1, 1, At, B1); PG8_BAR; PG8_SCHED;
            } else {
            PG8_LDB(B0, 0, 0); PG8_SCHED; PG8_LDA(At, 0, 0); PG8_STAGE(PG8_SA(1, 1), a1 + hstepA, voffA);
            PG8_WAIT_L(8); PG8_BAR; PG8_WAIT_L(0); PG8_MMA(0, 0, At, B0); PG8_BAR; PG8_SCHED;
            PG8_LDB(B1, 0, 1); PG8_STAGE(PG8_SB(0, 0), b2, voffB);
            PG8_BAR; PG8_WAIT_L(0); PG8_MMA(0, 1, At, B1); PG8_BAR;
            PG8_LDA(At, 0, 1); PG8_STAGE(PG8_SA(0, 0), a2, voffA);
            PG8_BAR; PG8_WAIT_L(0); PG8_MMA(1, 0, At, B0); PG8_BAR; PG8_SCHED;
            PG8_STAGE(PG8_SB(0, 1), b2 + hstepB, voffB);
            PG8_WAIT_V(6); PG8_BAR; PG8_MMA(1, 1, At, B1); PG8_BAR;
            PG8_LDB(B0, 1, 0); PG8_SCHED; PG8_LDA(At, 1, 0); PG8_STAGE(PG8_SA(0, 1), a2 + hstepA, voffA);
            PG8_WAIT_L(8); PG8_BAR; PG8_WAIT_L(0); PG8_MMA(0, 0, At, B0); PG8_BAR; PG8_SCHED;
            PG8_LDB(B1, 1, 1); PG8_STAGE(PG8_SB(1, 0), b3, voffB);
            PG8_BAR; PG8_WAIT_L(0); PG8_MMA(0, 1, At, B1); PG8_BAR;
            PG8_LDA(At, 1, 1); PG8_STAGE(PG8_SA(1, 0), a3, voffA);
            PG8_BAR; PG8_WAIT_L(0); PG8_MMA(1, 0, At, B0); PG8_BAR; PG8_SCHED;
            PG8_STAGE(PG8_SB(1, 1), b3 + hstepB, voffB);
            PG8_WAIT_V(6); PG8_BAR; PG8_MMA(1, 1, At, B1); PG8_BAR;
            }
        }
        if constexpr (ALIGN_EPI) { if (wr == 0) PG8_BAR; }
        if constexpr (!Epi::AFTER_DRAIN) { E(acc, cur, wr, wc, fr, fq); S.done(cur); }
        if (!has_next) break;
#pragma unroll
        for (int a = 0; a < 2; ++a)
#pragma unroll
            for (int b = 0; b < 2; ++b)
#pragma unroll
                for (int m = 0; m < 4; ++m)
#pragma unroll
                    for (int n = 0; n < 2; ++n) acc[a][b][m][n] = (f32x4){0.f, 0.f, 0.f, 0.f};
        cur = nxt; cA = nA; cB = nB; ++ui;
        if constexpr (ALIGN_EPI) { if (wr == 1) PG8_BAR; }
    }
    PG8_WAIT_V(0);
    if constexpr (!ALIGN_EPI) { if (wr == 0) PG8_BAR; }
    PG8_BAR;
    if constexpr (Epi::AFTER_DRAIN) { E.fused(acc, cur, wr, wc, fr, fq, lds, wid, lane); S.done(cur); }
#undef PG8_SA
#undef PG8_SB
#undef PG8_STAGE
#undef PG8_LDA
#undef PG8_LDB
#undef PG8_MMA
#undef PG8_WAIT_V
#undef PG8_WAIT_L
#undef PG8_BAR
#undef PG8_SCHED
}
}
#define GAS __attribute__((address_space(1)))
#define LAS __attribute__((address_space(3)))
typedef unsigned short bf16;
typedef unsigned v4u __attribute__((ext_vector_type(4)));
typedef float f32x4 __attribute__((ext_vector_type(4)));
typedef short bf16x8 __attribute__((ext_vector_type(8)));
typedef GAS unsigned gu32;
typedef GAS unsigned long long gu64;
#define RLX_AGENT __ATOMIC_RELAXED, __HIP_MEMORY_SCOPE_AGENT
#define LDS_WAIT() asm volatile("s_waitcnt lgkmcnt(0)" ::: "memory")
#define VM_WAIT() asm volatile("s_waitcnt vmcnt(0)" ::: "memory")
__device__ __forceinline__ unsigned long long rt() { return __builtin_amdgcn_s_memrealtime(); }
__device__ __forceinline__ unsigned f2bf(float f) { unsigned u = __builtin_bit_cast(unsigned, f); return (u + 0x7fffu + ((u >> 16) & 1u)) >> 16; }
__device__ __forceinline__ unsigned pk2(float lo, float hi) { return f2bf(lo) | (f2bf(hi) << 16); }

#define XB_TMO      128
#define XB_XCNT(j)  (256  + 64 * (j))
#define XB_XSUB(j)  (1280 + 64 * (j))
#define XB_XGEN(j)  (2304 + 64 * (j))
#define XB_TOP      3328
#define XB_TOPGEN   3392
#define XCD_BAR_WORDS 3456
#define XB_SPIN_CAP (1u << 18)

__device__ __forceinline__ unsigned xb_ld(unsigned* p)              { return __hip_atomic_load(p, __ATOMIC_RELAXED, __HIP_MEMORY_SCOPE_AGENT); }
__device__ __forceinline__ unsigned xb_add(unsigned* p, unsigned v) { return __hip_atomic_fetch_add(p, v, __ATOMIC_RELAXED, __HIP_MEMORY_SCOPE_AGENT); }
__device__ __forceinline__ unsigned xb_xcc_id() { return (unsigned)__builtin_amdgcn_s_getreg((3 << 11) | 20) & 0xFu; }
#define XB_SPIN(cond, bar) do { unsigned _sp = 0; while (cond) { __builtin_amdgcn_s_sleep(1); \
    if ((++_sp & 255u) == 0u) { if (xb_ld(&(bar)[XB_TMO])) break; if (_sp > XB_SPIN_CAP) { atomicAdd(&(bar)[XB_TMO], 1u); break; } } } } while (0)

struct XcdBarrier {
    unsigned* bar; unsigned x;
    volatile LAS unsigned* st;
};

__device__ __forceinline__ XcdBarrier xcd_barrier_post(unsigned* bar, volatile LAS unsigned* st) {
    XcdBarrier b; b.bar = bar; b.x = xb_xcc_id(); b.st = st;
    if (threadIdx.x == 0) (void)xb_add(&bar[XB_XCNT(b.x)], 1u);
    return b;
}
__device__ __forceinline__ void xcd_barrier_complete(unsigned* bar, unsigned x, unsigned& nloc, unsigned& nx) {
    const unsigned G = gridDim.x * gridDim.y * gridDim.z;
    unsigned sum, cnt, mine, sp = 0u;
    for (;;) {
        sum = 0u; cnt = 0u; mine = 0u;
#pragma unroll
        for (unsigned j = 0; j < 16; ++j) { const unsigned c = xb_ld(&bar[XB_XCNT(j)]); sum += c; cnt += (c > 0u) ? 1u : 0u; mine = (j == x) ? c : mine; }
        if (sum == G) break;
        __builtin_amdgcn_s_sleep(1);
        if ((++sp & 255u) == 0u) { if (xb_ld(&bar[XB_TMO])) break; if (sp > XB_SPIN_CAP) { atomicAdd(&bar[XB_TMO], 1u); break; } }
    }
    nloc = mine > 0u ? mine : 1u; nx = cnt > 0u ? cnt : 1u;
}

__device__ __forceinline__ void xcd_barrier(const XcdBarrier& b) {
    asm volatile("s_waitcnt vmcnt(0)" ::: "memory");
    __syncthreads();
    if (threadIdx.x == 0) {
        unsigned* bar = b.bar;
        __builtin_amdgcn_s_waitcnt(0);
        unsigned nloc = b.st[0], nx = b.st[1];
        if (nloc == 0u) { xcd_barrier_complete(bar, b.x, nloc, nx); b.st[0] = nloc; b.st[1] = nx; }
        const unsigned old = xb_add(&bar[XB_XSUB(b.x)], 1u);
        const unsigned gen = old / nloc;
        if (old + 1u == (gen + 1u) * nloc) {
            __builtin_amdgcn_fence(__ATOMIC_RELEASE, "agent");
            asm volatile("s_waitcnt vmcnt(0)" ::: "memory");
            const unsigned og = xb_add(&bar[XB_TOP], 1u);
            const unsigned tg = og / nx;
            if (og + 1u == (tg + 1u) * nx) xb_add(&bar[XB_TOPGEN], 1u);
            else XB_SPIN(xb_ld(&bar[XB_TOPGEN]) == tg, bar);
            __builtin_amdgcn_fence(__ATOMIC_ACQUIRE, "agent");
            xb_add(&bar[XB_XGEN(b.x)], 1u);
            asm volatile("s_waitcnt vmcnt(0)" ::: "memory");
        } else {
            XB_SPIN(xb_ld(&bar[XB_XGEN(b.x)]) == gen, bar);
            __builtin_amdgcn_fence(__ATOMIC_ACQUIRE, "agent");
            asm volatile("s_waitcnt vmcnt(0)" ::: "memory");
        }
    }
    __syncthreads();
}
constexpr int NWAVES = 8;
constexpr int DM = 2048, SEQ = 16384, DEPTH = 4, DEC_B = 16, DEC_T = 32, MS = DEC_B * DEC_T, M = SEQ + MS;
constexpr int DFF = 5632, DIN = 3584, DPOOL = 512, DSGU = 768, DCONV = 768, CONVK = 31, ZP = 2816;
constexpr int NGU = 2 * DFF;
constexpr float EPS = 1e-6f;
#ifndef MK_MULTI
#define MK_MULTI 0
#endif
constexpr int NPHASE = 1 + 10 * DEPTH;
#ifndef PR_CVT
#define PR_CVT 1
#endif
#ifndef PR_MIX
#define PR_MIX 1
#endif
#ifndef PR_GU
#define PR_GU 1
#endif
#ifndef PR_D
#define PR_D 1
#endif
#ifndef PR_WIN
#define PR_WIN 1
#endif
#ifndef PR_DS
#define PR_DS 1
#endif
#ifndef PR_N
#define PR_N 0
#endif
#ifndef PR_GUX
#define PR_GUX 0
#endif
#ifndef PR_BAR
#define PR_BAR 1
#endif
#ifndef PR_CUT
#define PR_CUT 0
#endif
#ifndef PR_SGU
#define PR_SGU 1
#endif
#ifndef PR_CONV
#define PR_CONV 1
#endif
#ifndef PR_POOL
#define PR_POOL 1
#endif
constexpr size_t O_Y = 0, O_POOLP = (size_t)M * DM, O_CONVP = O_POOLP + (size_t)DEPTH * 15 * DPOOL, O_POOLS = O_CONVP + (size_t)DEPTH * 30 * DCONV,
                 O_CONVS = O_POOLS + (size_t)DEPTH * DEC_B * 15 * DPOOL, O_V = O_CONVS + (size_t)DEPTH * DEC_B * 30 * DCONV, O_END = O_V + (size_t)DEPTH * DEC_B * DEC_T * DSGU;
constexpr size_t MiB = 1u << 20;
constexpr size_t WS_CTL = 0, CTL_ZERO_BYTES = 1 * MiB;
constexpr size_t WS_PWT = 1 * MiB;
constexpr size_t WS_SGA = WS_PWT + 512 * 1024;
constexpr size_t WS_SGAS = WS_SGA + 768 * 1024;
constexpr size_t WS_ROWSTAT = 4 * MiB;
constexpr size_t WS_W = 8 * MiB;
constexpr size_t WL_GU1 = 0, WL_D1 = (size_t)NGU * DM, WL_IN = WL_D1 + (size_t)DM * DFF, WL_OUT = WL_IN + (size_t)DIN * DM, WL_GU2 = WL_OUT + (size_t)DM * DM,
                 WL_D2 = WL_GU2 + (size_t)NGU * DM, WL_TOTAL = WL_D2 + (size_t)DM * DFF;
constexpr size_t WS_H = 624 * MiB;
constexpr size_t WS_CAT = 690 * MiB;
constexpr size_t WS_Y = 756 * MiB;
constexpr size_t WS_HID = 888 * MiB;
constexpr size_t WS_Z = WS_HID;
constexpr size_t WS_SLAB = 1070 * MiB;
constexpr size_t WS_END = 1116 * MiB;
constexpr int KS_D = 11, KS_O = 8;
static_assert(WS_W + 4 * WL_TOTAL * 2 <= WS_H && WS_H + (size_t)M * DM * 2 <= WS_CAT && WS_CAT + (size_t)M * DM * 2 <= WS_Y && WS_Y + (size_t)M * DM * 4 <= WS_HID && WS_HID + (size_t)M * DFF * 2 <= WS_SLAB && WS_SLAB + (size_t)KS_D * MS * DM * 4 <= WS_END, "ws map");
static_assert(WS_ROWSTAT + (size_t)M * 12 * 4 <= WS_W && WS_SGAS + 768 * 1024 <= WS_ROWSTAT, "ws map small");
constexpr int CW_TMO = 0, CW_BAR = 4096;
constexpr int RING_OFF = 0, RING_BYTES = 131072, LDSCTL_OFF = RING_BYTES, MISC_OFF = LDSCTL_OFF + 320, LDS_BYTES = 147456;
constexpr int HTB = pg8::HTB;

typedef float f32x2 __attribute__((ext_vector_type(2)));
typedef unsigned u32x2 __attribute__((ext_vector_type(2)));
__device__ __forceinline__ float bf2f(unsigned short b) { return __builtin_bit_cast(float, (unsigned)b << 16); }
__device__ __forceinline__ float bflo(unsigned u) { return __builtin_bit_cast(float, u << 16); }
__device__ __forceinline__ float bfhi(unsigned u) { return __builtin_bit_cast(float, u & 0xffff0000u); }
__device__ __forceinline__ float wave_sum(float v) {
#pragma unroll
    for (int o = 1; o < 64; o <<= 1) v += __shfl_xor(v, o);
    return v;
}

struct Args { const float* in[19]; float* out; unsigned char* ws; int ph_lo, ph_hi; };
struct Frame { LAS unsigned char* lds; volatile LAS unsigned* MISC; gu32* ctl; int vcu, G; };
struct Tid { int tid, lane, wave; };
__device__ __forceinline__ Tid get_tid() { Tid t; t.tid = pg8::opaque_tid(); t.lane = t.tid & 63; t.wave = __builtin_amdgcn_readfirstlane(t.tid >> 6); return t; }

constexpr int IPL = 19712, IT_GU1 = 0, IT_D1 = 5632, IT_GU2 = 11264, IT_D2 = 16896;
struct CvtItem { const float* src; bf16* dst; int N, K; };
__device__ __forceinline__ CvtItem cvt_decode(const Args& a, int git, int lane) {
    const int l = git / IPL; int r = git % IPL;
    bf16* wl = (bf16*)(a.ws + WS_W) + (size_t)l * WL_TOTAL;
    const float* src; int N, K; bf16* dst; int kind;
    if (r < 2816)       { src = a.in[5] + (size_t)(l * 2 + 0) * DM * DFF; N = DFF; K = DM; dst = wl + WL_GU1; kind = 1; }
    else if (r < 5632)  { r -= 2816;  src = a.in[6] + (size_t)(l * 2 + 0) * DM * DFF; N = DFF; K = DM; dst = wl + WL_GU1; kind = 2; }
    else if (r < 8448)  { r -= 5632;  src = a.in[7] + (size_t)(l * 2 + 0) * DFF * DM; N = DM; K = DFF; dst = wl + WL_D1; kind = 0; }
    else if (r < 10240) { r -= 8448;  src = a.in[8] + (size_t)l * DM * DIN; N = DIN; K = DM; dst = wl + WL_IN; kind = 3; }
    else if (r < 11264) { r -= 10240; src = a.in[18] + (size_t)l * DM * DM; N = DM; K = DM; dst = wl + WL_OUT; kind = 0; }
    else if (r < 14080) { r -= 11264; src = a.in[5] + (size_t)(l * 2 + 1) * DM * DFF; N = DFF; K = DM; dst = wl + WL_GU2; kind = 1; }
    else if (r < 16896) { r -= 14080; src = a.in[6] + (size_t)(l * 2 + 1) * DM * DFF; N = DFF; K = DM; dst = wl + WL_GU2; kind = 2; }
    else                { r -= 16896; src = a.in[7] + (size_t)(l * 2 + 1) * DFF * DM; N = DM; K = DFF; dst = wl + WL_D2; kind = 0; }
    const int nb = N >> 6, kb = r / nb, cb = r % nb, n0 = cb * 64, k0 = kb * 64; int drow0 = n0;
    if (kind == 1) drow0 = 256 * (n0 >> 7) + (n0 & 127);
    else if (kind == 2) drow0 = 256 * (n0 >> 7) + 128 + (n0 & 127);
    else if (kind == 3) { if (n0 >= 2816) drow0 = 2048 + 256 * ((n0 - 2816) >> 7) + 128 + ((n0 - 2816) & 127); else if (n0 >= 2048) drow0 = 2048 + 256 * ((n0 - 2048) >> 7) + ((n0 - 2048) & 127); }
    CvtItem c; c.src = src + (size_t)(k0 + (lane >> 4)) * N + n0 + 4 * (lane & 15); c.dst = dst + ((size_t)(drow0 >> 8) * (K >> 6) + (k0 >> 6)) * 16384 + (size_t)(drow0 & 255) * 64; c.N = N; c.K = K; return c;
}
__device__ __forceinline__ void cvt_load(f32x4 (&v)[16], const CvtItem& c) {
#pragma unroll
    for (int i = 0; i < 16; ++i) v[i] = *(const f32x4*)(c.src + (size_t)(4 * i) * c.N);
}
__device__ __forceinline__ void cvt_finish(const f32x4 (&v)[16], const CvtItem& c, LAS unsigned short* scr, int lane) {
#pragma unroll
    for (int i = 0; i < 16; ++i) { const int kl = 4 * i + (lane >> 4), nl = 4 * (lane & 15);
#pragma unroll
        for (int j = 0; j < 4; ++j) scr[(nl + j) * 72 + kl] = (unsigned short)f2bf(v[i][j]); }
    LDS_WAIT(); asm volatile("" ::: "memory");
#pragma unroll
    for (int j = 0; j < 8; ++j) { const int nl = (lane >> 3) + 8 * j, cc = lane & 7;
        const v4u o = *(const LAS v4u*)(scr + nl * 72 + 8 * cc);
        *(v4u*)(c.dst + nl * 64 + 8 * cc) = o; }
    LDS_WAIT(); asm volatile("" ::: "memory");
}
__device__ __forceinline__ void convert_range(const Frame& F, const Args& a, int g0, int g1, int cu, int ncu) {
    const Tid t = get_tid();
    LAS unsigned short* scr = (LAS unsigned short*)(F.lds + RING_OFF + t.wave * 9216);
    const int stride = ncu * NWAVES; int it = g0 + cu * NWAVES + t.wave;
    f32x4 v[16], vn[16]; CvtItem c, cn;
    if (it < g1) { c = cvt_decode(a, it, t.lane); cvt_load(v, c); }
    while (it < g1) {
        const int nx = it + stride;
        if (nx < g1) { cn = cvt_decode(a, nx, t.lane); cvt_load(vn, cn); }
        cvt_finish(v, c, scr, t.lane);
#pragma unroll
        for (int i = 0; i < 16; ++i) v[i] = vn[i];
        c = cn; it = nx;
    }
}
__device__ __forceinline__ void convert_small(const Frame& F, const Args& a) {
    const Tid t = get_tid();
    const int gt = F.vcu * (NWAVES * 64) + t.tid, NGT = F.G * NWAVES * 64;
    bf16* pwt = (bf16*)(a.ws + WS_PWT); bf16* sga = (bf16*)(a.ws + WS_SGA); bf16* sgas = (bf16*)(a.ws + WS_SGAS);
    for (int e = gt; e < DEPTH * 4 * 16384; e += NGT) { const int c = e & 127, d = (e >> 7) & 127, lg = e >> 14; pwt[e] = (bf16)f2bf(a.in[9][(size_t)lg * 16384 + c * 128 + d]); }
    for (int e = gt; e < DEPTH * 6 * 16384; e += NGT) { const int k = e & 127, q = (e >> 7) & 127, lh = e >> 14;
        sga[e] = (bf16)(k <= q ? f2bf(a.in[12][e]) : 0u);
        const int bq = q >> 5, qq = q & 31, bk = k >> 5, kk = k & 31;
        sgas[e] = (bf16)((bq == bk && kk <= qq) ? f2bf(a.in[12][(size_t)lh * 16384 + qq * 128 + kk]) : 0u); }
}

struct NRow { f32x4 x[8]; u32x2 y[8]; };
template <int MODE> __device__ __forceinline__ void nrow_load(NRow& r, const Args& a, int m, int lane) {
    if (MODE == 0) { const float* src = m < SEQ ? a.in[0] + (size_t)m * DM : a.in[1] + (size_t)(m - SEQ) * DM;
#pragma unroll
        for (int j = 0; j < 8; ++j) r.x[j] = *((const f32x4*)src + lane + 64 * j);
    } else { const float* X = a.out + O_Y + (size_t)m * DM; const bf16* Y = (const bf16*)(a.ws + WS_Y) + (size_t)m * DM;
#pragma unroll
        for (int j = 0; j < 8; ++j) { r.x[j] = *((const f32x4*)X + lane + 64 * j); r.y[j] = *((const u32x2*)Y + lane + 64 * j); } }
}
template <int MODE> __device__ __forceinline__ void nrow_finish(f32x4 (&xv)[8], float* Xo, bf16* Ho, int m, int lane, const f32x4 (&gq)[8]) {
    float* X = Xo + (size_t)m * DM; bf16* H = Ho + (size_t)m * DM;
#pragma unroll
    for (int j = 0; j < 8; ++j) *((f32x4*)X + lane + 64 * j) = xv[j];
    if (MODE != 2) {
        float s2 = 0.f;
#pragma unroll
        for (int j = 0; j < 8; ++j) s2 += (xv[j][0] * xv[j][0] + xv[j][1] * xv[j][1]) + (xv[j][2] * xv[j][2] + xv[j][3] * xv[j][3]);
        const float r2 = 1.0f / sqrtf(wave_sum(s2) * (1.0f / DM) + EPS);
#pragma unroll
        for (int j = 0; j < 8; ++j) { const f32x4 o = (xv[j] * r2) * gq[j]; u32x2 w; w.x = pg8::cvt_pk_bf16(o[0], o[1]); w.y = pg8::cvt_pk_bf16(o[2], o[3]);
            *((u32x2*)H + lane + 64 * j) = w; }
    }
}
template <int MODE> __device__ __forceinline__ void norm_phase(const Frame& F, const Args& a, const float* gpost, float scale, const float* gpre, int nslab, bool dummy = false) {
    float* Xo = dummy ? (float*)(a.ws + WS_END) : a.out + O_Y; bf16* Ho = dummy ? (bf16*)(a.ws + WS_END + 140 * MiB) : (bf16*)(a.ws + WS_H);
    const Tid t = get_tid(); const int lane = t.lane;
    const int gw = F.vcu * NWAVES + t.wave, NGW = F.G * NWAVES;
    f32x4 gp[8], gq[8];
#pragma unroll
    for (int j = 0; j < 8; ++j) { gp[j] = (MODE != 0) ? *((const f32x4*)gpost + lane + 64 * j) : (f32x4){0.f, 0.f, 0.f, 0.f}; gq[j] = (MODE != 2) ? *((const f32x4*)gpre + lane + 64 * j) : (f32x4){0.f, 0.f, 0.f, 0.f}; }
    const int MEND = (MODE == 0) ? M : SEQ;
    int m = gw; NRow cur, nxt;
    if (m < MEND) nrow_load<MODE>(cur, a, m, lane);
    while (m < MEND) {
        const int mn = m + NGW;
        if (mn < MEND) nrow_load<MODE>(nxt, a, mn, lane);
        if (MODE != 0) { float s = 0.f; f32x4 yv[8];
#pragma unroll
            for (int j = 0; j < 8; ++j) { yv[j] = (f32x4){bflo(cur.y[j].x), bfhi(cur.y[j].x), bflo(cur.y[j].y), bfhi(cur.y[j].y)}; s += (yv[j][0] * yv[j][0] + yv[j][1] * yv[j][1]) + (yv[j][2] * yv[j][2] + yv[j][3] * yv[j][3]); }
            const float r = scale / sqrtf(wave_sum(s) * (1.0f / DM) + EPS);
#pragma unroll
            for (int j = 0; j < 8; ++j) cur.x[j] = cur.x[j] + (yv[j] * r) * gp[j]; }
        nrow_finish<MODE>(cur.x, Xo, Ho, m, lane, gq);
        cur = nxt; m = mn;
    }
    if (MODE != 0) {
        const float* SL = (const float*)(a.ws + WS_SLAB);
        for (int ms = gw; ms < MS; ms += NGW) { const int mr = SEQ + ms;
            f32x4 yv[8], xv[8];
#pragma unroll
            for (int j = 0; j < 8; ++j) { xv[j] = *((const f32x4*)(a.out + O_Y + (size_t)mr * DM) + lane + 64 * j); yv[j] = *((const f32x4*)(SL + (size_t)ms * DM) + lane + 64 * j); }
            for (int k = 1; k < nslab; ++k) {
#pragma unroll
                for (int j = 0; j < 8; ++j) yv[j] = yv[j] + *((const f32x4*)(SL + ((size_t)k * MS + ms) * DM) + lane + 64 * j); }
            float s = 0.f;
#pragma unroll
            for (int j = 0; j < 8; ++j) s += (yv[j][0] * yv[j][0] + yv[j][1] * yv[j][1]) + (yv[j][2] * yv[j][2] + yv[j][3] * yv[j][3]);
            const float r = scale / sqrtf(wave_sum(s) * (1.0f / DM) + EPS);
#pragma unroll
            for (int j = 0; j < 8; ++j) xv[j] = xv[j] + (yv[j] * r) * gp[j];
            nrow_finish<MODE>(xv, Xo, Ho, mr, lane, gq);
        }
    }
}

__device__ __forceinline__ void quad_mma(LAS unsigned char* la, LAS unsigned char* lb, int wr, int wc, int fr, int fq, f32x4 (&acc)[4][2]) {
    const int aoff = pg8::lds_byte(wr * 64 + fr, fq * 8), boff = pg8::lds_byte(wc * 32 + fr, fq * 8);
#pragma unroll
    for (int m = 0; m < 4; ++m)
#pragma unroll
        for (int n = 0; n < 2; ++n) acc[m][n] = (f32x4){0.f, 0.f, 0.f, 0.f};
#pragma unroll
    for (int kb = 0; kb < 2; ++kb) {
        bf16x8 At[4][2], Bf[2][2];
#pragma unroll
        for (int m = 0; m < 4; ++m)
#pragma unroll
            for (int k = 0; k < 2; ++k) At[m][k] = *(const LAS bf16x8*)(la + kb * HTB + aoff + m * 2048 + k * 1024);
#pragma unroll
        for (int n = 0; n < 2; ++n)
#pragma unroll
            for (int k = 0; k < 2; ++k) Bf[n][k] = *(const LAS bf16x8*)(lb + kb * HTB + boff + n * 2048 + k * 1024);
#pragma unroll
        for (int m = 0; m < 4; ++m)
#pragma unroll
            for (int n = 0; n < 2; ++n)
#pragma unroll
                for (int k = 0; k < 2; ++k) acc[m][n] = __builtin_amdgcn_mfma_f32_16x16x32_bf16(Bf[n][k], At[m][k], acc[m][n], 0, 0, 0);
    }
}
__device__ __forceinline__ void stage_image(const bf16* src, LAS unsigned char* img, int tid) {
#pragma unroll
    for (int kb = 0; kb < 2; ++kb)
#pragma unroll
        for (int i = 0; i < 2; ++i) { const int b = tid * 16 + i * 8192; int R, C; pg8::stage_rc(b, R, C);
            *(LAS v4u*)(img + kb * HTB + b) = *(const v4u*)(src + R * 128 + kb * 64 + C); }
}

__device__ __forceinline__ void pool_unit(const Frame& F, const Args& a, int l, int T, int g) {
    LAS unsigned short* PB = (LAS unsigned short*)(F.lds + 0);
    LAS unsigned char* LA = F.lds + 49152; LAS unsigned char* LB = F.lds + 81920;
    const bf16* Z = (const bf16*)(a.ws + WS_Z); bf16* CAT = (bf16*)(a.ws + WS_CAT);
    const Tid t = get_tid(); const int r0 = 128 * T; const bool sample = r0 >= SEQ; const int tid = t.tid;
    __syncthreads();
    stage_image((const bf16*)(a.ws + WS_PWT) + (size_t)(l * 4 + g) * 16384, LB, tid);
    for (int it = tid; it < 4 * 47 * 16; it += NWAVES * 64) {
        const int seg = it / 752, rem = it % 752, rr = rem >> 4, ch = rem & 15;
        v4u val = (v4u){0u, 0u, 0u, 0u};
        if (sample && rr < 15) { const int b = ((r0 - SEQ) >> 5) + seg; const float* s = a.in[2] + ((size_t)(l * DEC_B + b) * 15 + rr) * DPOOL + g * 128 + 8 * ch;
            const f32x4 p0 = *(const f32x4*)s, p1 = *(const f32x4*)(s + 4);
            val.x = pg8::cvt_pk_bf16(p0[0], p0[1]); val.y = pg8::cvt_pk_bf16(p0[2], p0[3]); val.z = pg8::cvt_pk_bf16(p1[0], p1[1]); val.w = pg8::cvt_pk_bf16(p1[2], p1[3]);
        } else { const int row = r0 + 32 * seg + rr - 15; if (row >= 0) val = *(const v4u*)(Z + (size_t)row * ZP + g * 128 + 8 * ch); }
        *(LAS v4u*)(PB + (seg * 47 + rr) * 128 + 8 * ch) = val;
    }
    __syncthreads();
    { const int c = tid & 127, seg = tid >> 7, w = 2 << g;
        const LAS unsigned short* p = PB + (seg * 47 + 15) * 128 + c; float s = 0.f;
        for (int j = 1; j < w; ++j) s += bf2f(p[-j * 128]);
        for (int tau = 0; tau < 32; ++tau) {
            const float cur = bf2f(p[tau * 128]); s += cur;
            const int pos1 = r0 + 32 * seg + tau + 1; const int cnt = (sample || pos1 > w) ? w : pos1;
            const float pooled = s / (float)cnt - cur;
            *(LAS unsigned short*)(LA + (c >> 6) * HTB + pg8::lds_byte(32 * seg + tau, c & 63)) = (unsigned short)f2bf(pooled);
            s -= bf2f(p[(tau + 1 - w) * 128]);
        } }
    __syncthreads();
    const int wr = t.wave >> 2, wc = t.wave & 3, fr = t.lane & 15, fq = t.lane >> 4;
    f32x4 acc[4][2]; quad_mma(LA, LB, wr, wc, fr, fq, acc);
    const float* sc = a.in[10] + l * DPOOL + g * 128;
#pragma unroll
    for (int m = 0; m < 4; ++m)
#pragma unroll
        for (int n = 0; n < 2; ++n) { const int row = r0 + 64 * wr + 16 * m + fr, col = 32 * wc + 16 * n + 4 * fq; const f32x4 s4 = *(const f32x4*)(sc + col), o = acc[m][n] * s4;
            u32x2 w2; w2.x = pg8::cvt_pk_bf16(o[0], o[1]); w2.y = pg8::cvt_pk_bf16(o[2], o[3]); *(u32x2*)(CAT + (size_t)row * DM + g * 128 + col) = w2; }
}

__device__ __forceinline__ void sgu_unit(const Frame& F, const Args& a, int l, int T, int h) {
    LAS unsigned char* LA = F.lds + 0; LAS unsigned char* LB = F.lds + 32768; LAS float* RS = (LAS float*)(F.lds + 65536);
    const bf16* Z = (const bf16*)(a.ws + WS_Z); bf16* CAT = (bf16*)(a.ws + WS_CAT); const float* rowstat = (const float*)(a.ws + WS_ROWSTAT);
    const Tid t = get_tid(); const int r0 = 128 * T; const bool sample = r0 >= SEQ; const int tid = t.tid;
    __syncthreads();
    if (tid < 128) { const f32x4* rs = (const f32x4*)(rowstat + (size_t)(r0 + tid) * 12); const f32x4 s0 = rs[0], s1 = rs[1], s2 = rs[2];
        const float s = ((s0[0] + s0[1]) + (s0[2] + s0[3])) + ((s1[0] + s1[1]) + (s1[2] + s1[3])) + ((s2[0] + s2[1]) + (s2[2] + s2[3]));
        RS[tid] = 1.0f / sqrtf(s * (1.0f / DSGU) + EPS); }
    stage_image((const bf16*)(a.ws + (sample ? WS_SGAS : WS_SGA)) + (size_t)(l * 6 + h) * 16384, LA, tid);
    __syncthreads();
#pragma unroll
    for (int i = 0; i < 4; ++i) { const int it = tid + 512 * i, k = it >> 4, ch = it & 15;
        const v4u gv = *(const v4u*)(Z + (size_t)(r0 + k) * ZP + 1280 + 128 * h + 8 * ch);
        const float r = RS[k]; const float* gp = a.in[11] + l * DSGU + 128 * h + 8 * ch; const f32x4 g0 = *(const f32x4*)gp, g1 = *(const f32x4*)(gp + 4);
        float v[8]; v[0] = bflo(gv.x) * r * g0[0]; v[1] = bfhi(gv.x) * r * g0[1]; v[2] = bflo(gv.y) * r * g0[2]; v[3] = bfhi(gv.y) * r * g0[3];
        v[4] = bflo(gv.z) * r * g1[0]; v[5] = bfhi(gv.z) * r * g1[1]; v[6] = bflo(gv.w) * r * g1[2]; v[7] = bfhi(gv.w) * r * g1[3];
#pragma unroll
        for (int j = 0; j < 8; ++j) *(LAS unsigned short*)(LB + (k >> 6) * HTB + pg8::lds_byte(8 * ch + j, k & 63)) = (unsigned short)f2bf(v[j]);
        if (sample) { const int b = ((r0 - SEQ) >> 5) + (k >> 5), tau = k & 31; float* o = a.out + O_V + ((size_t)(l * DEC_B + b) * DEC_T + tau) * DSGU + 128 * h + 8 * ch;
            *(f32x4*)o = (f32x4){v[0], v[1], v[2], v[3]}; *(f32x4*)(o + 4) = (f32x4){v[4], v[5], v[6], v[7]}; }
    }
    __syncthreads();
    const int wr = t.wave >> 2, wc = t.wave & 3, fr = t.lane & 15, fq = t.lane >> 4;
    f32x4 acc[4][2]; quad_mma(LA, LB, wr, wc, fr, fq, acc);
    const float* sb = a.in[13] + (l * 6 + h) * 128;
#pragma unroll
    for (int m = 0; m < 4; ++m) { const int rl = 64 * wr + 16 * m + fr; const float bias = sb[sample ? (rl & 31) : rl];
#pragma unroll
        for (int n = 0; n < 2; ++n) { const int col = 512 + 128 * h + 32 * wc + 16 * n + 4 * fq; const u32x2 uu = *(const u32x2*)(Z + (size_t)(r0 + rl) * ZP + col);
            const f32x4 o = (f32x4){bflo(uu.x), bfhi(uu.x), bflo(uu.y), bfhi(uu.y)} * (acc[m][n] + bias);
            u32x2 w2; w2.x = pg8::cvt_pk_bf16(o[0], o[1]); w2.y = pg8::cvt_pk_bf16(o[2], o[3]); *(u32x2*)(CAT + (size_t)(r0 + rl) * DM + col) = w2; } }
}

__device__ __forceinline__ void conv_unit(const Frame& F, const Args& a, int l, int U) {
    LAS float* YB = (LAS float*)(F.lds + 0);
    const bf16* Z = (const bf16*)(a.ws + WS_Z); bf16* CAT = (bf16*)(a.ws + WS_CAT);
    const Tid t = get_tid(); const int r0 = 32 * U; const bool sample = r0 >= SEQ; const int tid = t.tid;
    __syncthreads();
    if (tid < 384) {
        const int ch = 2 * tid;
        unsigned win[62]; f32x2 wv[31];
#pragma unroll
        for (int i = 0; i < 62; ++i) {
            unsigned v = 0u;
            if (sample && i < 30) { const int b = (r0 - SEQ) >> 5; const f32x2 hv = *(const f32x2*)(a.in[3] + ((size_t)(l * DEC_B + b) * 30 + i) * DCONV + ch); v = pg8::cvt_pk_bf16(hv[0], hv[1]); }
            else { const int row = r0 - 30 + i; if (row >= 0) v = *(const unsigned*)(Z + (size_t)row * ZP + 2048 + ch); }
            win[i] = v;
        }
#pragma unroll
        for (int j = 0; j < 31; ++j) wv[j] = *(const f32x2*)(a.in[14] + ((size_t)l * CONVK + j) * DCONV + ch);
        const f32x2 cb = *(const f32x2*)(a.in[15] + l * DCONV + ch);
#pragma unroll
        for (int blk = 0; blk < 4; ++blk) {
            f32x2 y[8];
#pragma unroll
            for (int o = 0; o < 8; ++o) y[o] = cb;
#pragma unroll
            for (int i = 0; i < 38; ++i) { const unsigned u = win[8 * blk + i]; const f32x2 x = (f32x2){bflo(u), bfhi(u)};
#pragma unroll
                for (int o = 0; o < 8; ++o) { const int j = i - o; if (j >= 0 && j < 31) y[o] = y[o] + x * wv[j]; } }
#pragma unroll
            for (int o = 0; o < 8; ++o) *(LAS f32x2*)(YB + (8 * blk + o) * DCONV + ch) = y[o];
        }
    }
    __syncthreads();
    {
        const int lane = t.lane; f32x4 lg[3], lb[3];
#pragma unroll
        for (int j = 0; j < 3; ++j) { lg[j] = *(const f32x4*)(a.in[16] + l * DCONV + 4 * lane + 256 * j); lb[j] = *(const f32x4*)(a.in[17] + l * DCONV + 4 * lane + 256 * j); }
#pragma unroll
        for (int rr = 0; rr < 4; ++rr) { const int row = 4 * t.wave + rr;
            f32x4 v[3]; float s1 = 0.f, s2 = 0.f;
#pragma unroll
            for (int j = 0; j < 3; ++j) { v[j] = *(const LAS f32x4*)(YB + row * DCONV + 4 * lane + 256 * j); s1 += (v[j][0] + v[j][1]) + (v[j][2] + v[j][3]); s2 += (v[j][0] * v[j][0] + v[j][1] * v[j][1]) + (v[j][2] * v[j][2] + v[j][3] * v[j][3]); }
            s1 = wave_sum(s1); s2 = wave_sum(s2);
            const float mean = s1 * (1.0f / DCONV), var = s2 * (1.0f / DCONV) - mean * mean, rstd = 1.0f / sqrtf(fmaxf(var, 0.f) + EPS);
#pragma unroll
            for (int j = 0; j < 3; ++j) { const f32x4 z = ((v[j] - mean) * rstd) * lg[j] + lb[j];
                u32x2 w2; w2.x = pg8::cvt_pk_bf16(z[0] * pg8::sigmoid_f(z[0]), z[1] * pg8::sigmoid_f(z[1])); w2.y = pg8::cvt_pk_bf16(z[2] * pg8::sigmoid_f(z[2]), z[3] * pg8::sigmoid_f(z[3]));
                *(u32x2*)(CAT + (size_t)(r0 + row) * DM + 1280 + 4 * lane + 256 * j) = w2; } }
    }
}
__device__ __forceinline__ void state_copy(const Frame& F, const Args& a, int l) {
    const bf16* Z = (const bf16*)(a.ws + WS_Z); const Tid t = get_tid();
    const int gt = F.vcu * (NWAVES * 64) + t.tid, NGT = F.G * NWAVES * 64;
    for (int e = gt; e < 522240; e += NGT) {
        size_t zi, oi;
        if (e < 7680) { const int r = e >> 9, c = e & 511; zi = (size_t)(SEQ - 15 + r) * ZP + c; oi = O_POOLP + (size_t)l * 7680 + e; }
        else if (e < 30720) { const int e2 = e - 7680, r = e2 / 768, c = e2 % 768; zi = (size_t)(SEQ - 30 + r) * ZP + 2048 + c; oi = O_CONVP + (size_t)l * 23040 + e2; }
        else if (e < 153600) { const int e2 = e - 30720, b = e2 / 7680, rem = e2 % 7680, r = rem >> 9, c = rem & 511; zi = (size_t)(SEQ + b * 32 + 17 + r) * ZP + c; oi = O_POOLS + (size_t)(l * DEC_B + b) * 7680 + rem; }
        else { const int e2 = e - 153600, b = e2 / 23040, rem = e2 % 23040, r = rem / 768, c = rem % 768; zi = (size_t)(SEQ + b * 32 + 2 + r) * ZP + 2048 + c; oi = O_CONVS + (size_t)(l * DEC_B + b) * 23040 + rem; }
        a.out[oi] = bf2f(Z[zi]);
    }
}
__device__ __forceinline__ void mixer_phase(const Frame& F, const Args& a, int l) {
    constexpr int NT = M / 128, NSGU = NT * 6, NCONV = M / 32, NPOOL = NT * 4;
    for (int rep = 0; rep < PR_SGU; ++rep) for (int u = F.vcu; u < NSGU; u += F.G) sgu_unit(F, a, l, u / 6, u % 6);
    for (int rep = 0; rep < PR_CONV; ++rep) for (int u = (F.vcu + F.G - (NSGU % 256)) % F.G; u < NCONV; u += F.G) conv_unit(F, a, l, u);
    for (int rep = 0; rep < PR_POOL; ++rep) for (int u = (F.vcu + F.G - ((NSGU + NCONV) % 256)) % F.G; u < NPOOL; u += F.G) pool_unit(F, a, l, u >> 2, u & 3);
    state_copy(F, a, l);
}

__global__ void __launch_bounds__(NWAVES * 64, 2) fwd_kernel(Args args) {
    extern __shared__ __attribute__((aligned(16))) unsigned char lds[];
    Frame F;
    F.lds = (LAS unsigned char*)lds; F.MISC = (volatile LAS unsigned*)(F.lds + MISC_OFF);
    F.G = gridDim.x; { const int bx = blockIdx.x; F.vcu = (F.G % 8 == 0) ? (bx % 8) * (F.G / 8) + bx / 8 : bx; }
    F.ctl = (gu32*)(args.ws + WS_CTL);
    for (int u = threadIdx.x; u < (LDS_BYTES - LDSCTL_OFF) / 4; u += NWAVES * 64) ((LAS unsigned*)(F.lds + LDSCTL_OFF))[u] = 0u;
    __syncthreads();
    XcdBarrier bar; bar.bar = (unsigned*)(F.ctl + CW_BAR); bar.x = 0; bar.st = nullptr;
    if (!MK_MULTI) bar = xcd_barrier_post((unsigned*)(F.ctl + CW_BAR), F.MISC + 8);
    const int lo = args.ph_lo, hi = args.ph_hi;
#define IN(k) (lo <= (k) && (k) < hi)
#define SEAM(k) do { if (IN(k) && IN((k) + 1)) for (int rb = 0; rb < PR_BAR; ++rb) xcd_barrier(bar); } while (0)
    const float* ng = args.in[4];
    bf16* Wb = (bf16*)(args.ws + WS_W); bf16* H = (bf16*)(args.ws + WS_H); bf16* CAT = (bf16*)(args.ws + WS_CAT); bf16* HID = (bf16*)(args.ws + WS_HID); bf16* Z = (bf16*)(args.ws + WS_Z);
    bf16* Yb = (bf16*)(args.ws + WS_Y); float* SLAB = (float*)(args.ws + WS_SLAB); float* rowstat = (float*)(args.ws + WS_ROWSTAT);

    if (IN(0)) { for (int rep = 0; rep < PR_CVT; ++rep) convert_range(F, args, IT_GU1, IT_D1, F.vcu, F.G); convert_small(F, args); norm_phase<0>(F, args, nullptr, 0.f, ng, 0); }
    SEAM(0);
    for (int l0 = 0; l0 < DEPTH; ++l0) {
        for (int s0 = 0; s0 < 3; ++s0) {
            int l = l0, s = s0; asm volatile("" : "+s"(l), "+s"(s));
            const bf16* wl = Wb + (size_t)l * WL_TOTAL; const int pb = 1 + 10 * l;
            if (s != 1) {
                const int p0 = pb + (s ? 7 : 0);
                if (IN(p0)) {
#if PR_CUT
                    { pg8::Gemm g{H, wl + (s ? WL_GU2 : WL_GU1), M, NGU, DM, DM, DM, false, true}; pg8::RangeOrder S; S.S.init(M, NGU, F.G, (int)blockIdx.x); S.i0 = 0; S.i1 = 6; pg8::EpiSwiGLU E{HID, DFF};
                      pg8::gemm_phase<pg8::EpiSwiGLU, pg8::RangeOrder, true, true>(F.lds + RING_OFF, g, S, E); xcd_barrier(bar);
                      S.i0 = 6; S.i1 = 100; pg8::gemm_phase<pg8::EpiSwiGLU, pg8::RangeOrder, true, true>(F.lds + RING_OFF, g, S, E); }
#else
                    for (int rep = 0; rep < PR_GU; ++rep) { pg8::Gemm g{H, wl + (s ? WL_GU2 : WL_GU1), M, NGU, DM, DM, DM, false, true}; pg8::StaticOrder S; S.init(M, NGU, F.G, (int)blockIdx.x); pg8::EpiSwiGLU E{HID, DFF};
                    pg8::gemm_phase<pg8::EpiSwiGLU, pg8::StaticOrder, true, true>(F.lds + RING_OFF, g, S, E); }
#endif
                    const int rem = ((M / 256) * (NGU / 256)) % F.G, idle = (int)blockIdx.x - rem;
                    if (rem > 0 && idle >= 0) { const int gb = l * IPL;
                        if (s == 0) convert_range(F, args, gb + IT_D1, gb + IT_GU2 + 2816, idle, F.G - rem);
                        else convert_range(F, args, gb + IT_D2, (l + 1 < DEPTH) ? gb + IPL + IT_D1 : gb + IPL, idle, F.G - rem); } }
                if (IN(p0)) for (int rep = 0; rep < PR_GUX; ++rep) { pg8::Gemm g{H, wl + (s ? WL_GU2 : WL_GU1), M, NGU, DM, DM, DM, false, true}; pg8::DegenOrder S{12}; pg8::EpiSwiGLU E{Yb, DFF};
                    pg8::gemm_phase<pg8::EpiSwiGLU, pg8::DegenOrder, true, true>(F.lds + RING_OFF, g, S, E); }
                SEAM(p0);
                if (IN(p0 + 1)) {
                    for (int rep = 0; rep < PR_D; ++rep) { pg8::Gemm g{HID, wl + (s ? WL_D2 : WL_D1), SEQ, DM, DFF, DFF, DFF, false, true}; pg8::PanelOrder S{F.vcu}; pg8::EpiBf16Y E{Yb, DM};
                      pg8::gemm_phase<pg8::EpiBf16Y, pg8::PanelOrder, true, true>(F.lds + RING_OFF, g, S, E); }
                    for (int rep = 0; rep < PR_DS; ++rep) { pg8::Gemm g{HID, wl + (s ? WL_D2 : WL_D1), M, DM, DFF / KS_D, DFF, DFF, false, true}; pg8::SplitKOrder S{KS_D * 16, F.G, F.vcu, DM / 256, SEQ / 256, (DFF / KS_D) * 2, (DFF / KS_D / 64) * 32768}; pg8::EpiF32Y E{SLAB, DM, SEQ, (size_t)MS * DM};
                      pg8::gemm_phase<pg8::EpiF32Y, pg8::SplitKOrder, true, true>(F.lds + RING_OFF, g, S, E); } }
                SEAM(p0 + 1);
                if (IN(p0 + 2)) { const float* gpost = ng + (size_t)(l * 6 + (s ? 5 : 1)) * DM;
                    if (s == 0) norm_phase<1>(F, args, gpost, 0.5f, ng + (size_t)(l * 6 + 2) * DM, KS_D);
                    else if (l + 1 < DEPTH) norm_phase<1>(F, args, gpost, 0.5f, ng + (size_t)((l + 1) * 6 + 0) * DM, KS_D);
                    else norm_phase<2>(F, args, gpost, 0.5f, nullptr, KS_D); }
                SEAM(p0 + 2);
            } else {
                const int p0 = pb + 3;
                if (IN(p0)) { for (int rep = 0; rep < PR_WIN; ++rep) { pg8::Gemm g{H, wl + WL_IN, M, DIN, DM, DM, DM, false, true}; pg8::StaticOrder S; S.init(M, DIN, F.G, (int)blockIdx.x); pg8::EpiWin E{Z, ZP, rowstat};
                    pg8::gemm_phase<pg8::EpiWin, pg8::StaticOrder, true, true>(F.lds + RING_OFF, g, S, E); }
                    const int rem = ((M / 256) * (DIN / 256)) % F.G, idle = (int)blockIdx.x - rem;
                    if (rem > 0 && idle >= 0) convert_range(F, args, l * IPL + IT_GU2 + 2816, l * IPL + IT_D2, idle, F.G - rem); }
                SEAM(p0);
                if (IN(p0 + 1)) for (int rep = 0; rep < PR_MIX; ++rep) mixer_phase(F, args, l);
                SEAM(p0 + 1);
                if (IN(p0 + 2)) {
                    { pg8::Gemm g{CAT, wl + WL_OUT, SEQ, DM, DM, DM, DM, false, true}; pg8::PanelOrder S{F.vcu}; pg8::EpiBf16Y E{Yb, DM};
                      pg8::gemm_phase<pg8::EpiBf16Y, pg8::PanelOrder, true, true>(F.lds + RING_OFF, g, S, E); }
                    { pg8::Gemm g{CAT, wl + WL_OUT, M, DM, DM / KS_O, DM, DM, false, true}; pg8::SplitKOrder S{KS_O * 16, F.G, F.vcu, DM / 256, SEQ / 256, (DM / KS_O) * 2, (DM / KS_O / 64) * 32768}; pg8::EpiF32Y E{SLAB, DM, SEQ, (size_t)MS * DM};
                      pg8::gemm_phase<pg8::EpiF32Y, pg8::SplitKOrder, true, true>(F.lds + RING_OFF, g, S, E); } }
                SEAM(p0 + 2);
                if (IN(p0 + 3)) { for (int rep = 0; rep < PR_N; ++rep) norm_phase<1>(F, args, ng + (size_t)(l * 6 + 3) * DM, 1.0f, ng + (size_t)(l * 6 + 4) * DM, KS_O, true);
                    norm_phase<1>(F, args, ng + (size_t)(l * 6 + 3) * DM, 1.0f, ng + (size_t)(l * 6 + 4) * DM, KS_O); }
                SEAM(p0 + 3);
            }
        }
    }
#undef IN
#undef SEAM
}

extern "C" void kernel_launch(void* const* d_in, const int* in_sizes, int n_in, void* d_out, int out_size, void* d_ws, size_t ws_size, hipStream_t stream) {
    static int grid = 0;
    if (grid == 0) {
        if (n_in != 19 || (size_t)out_size != O_END || ws_size < WS_END) { fprintf(stderr, "kernel_launch: unexpected sizes: n_in %d out %d ws %zu (need %zu)\n", n_in, out_size, ws_size, (size_t)WS_END); grid = -1; return; }
        int dev = 0, cus = 0, per_cu = 0;
        if (hipGetDevice(&dev) != hipSuccess || hipDeviceGetAttribute(&cus, hipDeviceAttributeMultiprocessorCount, dev) != hipSuccess) { grid = -1; return; }
        if (hipFuncSetAttribute((const void*)fwd_kernel, hipFuncAttributeMaxDynamicSharedMemorySize, LDS_BYTES) != hipSuccess) { fprintf(stderr, "kernel_launch: hipFuncSetAttribute failed\n"); grid = -1; return; }
        if (hipOccupancyMaxActiveBlocksPerMultiprocessor(&per_cu, (const void*)fwd_kernel, NWAVES * 64, LDS_BYTES) != hipSuccess || per_cu < 1) fprintf(stderr, "kernel_launch: occupancy query says %d\n", per_cu);
        (void)hipGetLastError();
        grid = cus;
    }
    if (grid < 0) return;
    (void)hipMemsetAsync((char*)d_ws + WS_CTL, 0, CTL_ZERO_BYTES, stream);
    Args a{};
    for (int i = 0; i < 19; ++i) a.in[i] = (const float*)d_in[i];
    a.out = (float*)d_out; a.ws = (unsigned char*)d_ws;
#if MK_MULTI
    for (int p = 0; p < NPHASE; ++p) { a.ph_lo = p; a.ph_hi = p + 1; hipLaunchKernelGGL(fwd_kernel, dim3(grid), dim3(NWAVES * 64), LDS_BYTES, stream, a); }
#else
    a.ph_lo = 0; a.ph_hi = NPHASE; hipLaunchKernelGGL(fwd_kernel, dim3(grid), dim3(NWAVES * 64), LDS_BYTES, stream, a);
#endif
}
```
